# Optimizing an MI355X kernel written in HIP

```python
import math
import jax, jax.numpy as jnp
from jax import lax
import numpy as np

D_MODEL = 1024
BATCH = 32
SEQ = 2048
DEPTH = 2

HEAD_DIM = 64
A_WIDTH = 3 * D_MODEL // 8
HY_WIDTH = D_MODEL // 4
C_WIDTH = D_MODEL - A_WIDTH - HY_WIDTH
MIX_WIDTH = A_WIDTH + HY_WIDTH + C_WIDTH
A_HEADS = A_WIDTH // HEAD_DIM
DILATED_PATTERNS = ((128, 1), (512, 4), (2048, 16))
C_Q_HEADS = C_WIDTH // HEAD_DIM
C_GROUP = 3
C_KV_HEADS = C_Q_HEADS // C_GROUP
C_KV_WIDTH = C_KV_HEADS * HEAD_DIM
Q_BLOCK = 128
GRID_W = 64
ROPE_THETA = 10000.0
HY_ORDER = 2
HY_BANDS = 16
HY_EMB = 1 + 2 * HY_BANDS
HY_HIDDEN = 64
D_FF = 11 * D_MODEL // 4
EPS = 1e-6

A_Q0 = 0
A_K0 = A_Q0 + A_WIDTH
A_V0 = A_K0 + A_WIDTH
HY_0 = A_V0 + A_WIDTH
C_Q0 = HY_0 + (HY_ORDER + 1) * HY_WIDTH
C_K0 = C_Q0 + C_WIDTH
C_V0 = C_K0 + C_KV_WIDTH
PROJ_WIDTH = C_V0 + C_KV_WIDTH

kernel_name = "hybrid_dilated_hyena_axial_gqa_encoder"

F32 = jnp.float32


def rms_norm(x, g):
    xf = x.astype(F32)
    y = xf * lax.rsqrt(jnp.mean(xf * xf, axis=-1, keepdims=True) + EPS)
    return (y * g.astype(F32)).astype(x.dtype)


def rope_angles(pos, dim):
    freqs = ROPE_THETA ** (-jnp.arange(0, dim, 2, dtype=F32) / dim)
    ang = pos.astype(F32)[:, None] * freqs[None, :]
    return jnp.cos(ang), jnp.sin(ang)


def apply_rope(x, cos, sin):
    xf = x.astype(F32)
    half = x.shape[-1] // 2
    x1, x2 = xf[..., :half], xf[..., half:]
    c, s = cos[None, :, None, :], sin[None, :, None, :]
    return jnp.concatenate([x1 * c - x2 * s, x2 * c + x1 * s], axis=-1).astype(x.dtype)


def axial_rope(x, rows, cols):
    half = x.shape[-1] // 2
    cr, sr = rope_angles(rows, half)
    cc, sc = rope_angles(cols, half)
    return jnp.concatenate([apply_rope(x[..., :half], cr, sr), apply_rope(x[..., half:], cc, sc)], axis=-1)


def dwconv3(x, w, b):
    xp = jnp.pad(x, ((0, 0), (1, 1), (0, 0)))
    return xp[:, :-2] * w[0] + xp[:, 1:-1] * w[1] + xp[:, 2:] * w[2] + b


def dilated_branch(q, k, v, dilation, n_side):
    B, S, H, E = q.shape
    Ls = S // dilation
    blk = n_side
    nb = -(-Ls // blk)
    Lp = nb * blk

    def regroup(a):
        return a.reshape(B, Ls, dilation, H, E).transpose(0, 2, 3, 1, 4)

    qs = jnp.pad(regroup(q), ((0, 0), (0, 0), (0, 0), (0, Lp - Ls), (0, 0))).reshape(B, dilation, H, nb, blk, E)

    def windows(a):
        ap = jnp.pad(regroup(a), ((0, 0), (0, 0), (0, 0), (blk, Lp - Ls + blk), (0, 0)))
        ap = ap.reshape(B, dilation, H, nb + 2, blk, E)
        return jnp.concatenate([ap[:, :, :, :-2], ap[:, :, :, 1:-1], ap[:, :, :, 2:]], axis=4)

    kw, vw = windows(k), windows(v)
    qi = jnp.arange(nb)[:, None, None] * blk + jnp.arange(blk)[None, :, None]
    ki = jnp.arange(nb)[:, None, None] * blk - blk + jnp.arange(3 * blk)[None, None, :]
    valid = (jnp.abs(qi - ki) <= n_side) & (ki >= 0) & (ki < Ls)

    s = jnp.einsum('bdhnqe,bdhnke->bdhnqk', qs, kw).astype(F32) * (E ** -0.5)
    s = jnp.where(valid, s, -1e30)
    m = jnp.max(s, axis=-1, keepdims=True)
    p = jnp.exp(s - m)
    l = jnp.sum(p, axis=-1, keepdims=True)
    o = jnp.einsum('bdhnqk,bdhnke->bdhnqe', (p / l).astype(v.dtype), vw)
    lse = (m + jnp.log(l))[..., 0]

    o = o.reshape(B, dilation, H, Lp, E)[:, :, :, :Ls].transpose(0, 3, 1, 2, 4).reshape(B, S, H, E)
    lse = lse.reshape(B, dilation, H, Lp)[:, :, :, :Ls].transpose(0, 3, 1, 2).reshape(B, S, H)
    return o, lse


def dilated_attention(q, k, v):
    outs, lses = [], []
    for window, dilation in DILATED_PATTERNS:
        o, lse = dilated_branch(q, k, v, dilation, (window // 2) // dilation)
        outs.append(o)
        lses.append(lse)
    w = jax.nn.softmax(jnp.stack(lses, axis=0), axis=0)
    o = jnp.sum(w[..., None] * jnp.stack(outs, axis=0).astype(F32), axis=0)
    return o.astype(q.dtype)


def hyena_filters(L, w1, b1, freq, w2, b2, w3, decay):
    t = jnp.linspace(0.0, 1.0, L, dtype=F32)[:, None]
    bands = jnp.linspace(1e-4, HY_BANDS - 1, HY_BANDS, dtype=F32)
    ang = 2.0 * math.pi * bands[None, :] * jnp.arange(L, dtype=F32)[:, None] / L
    z = jnp.concatenate([t, jnp.cos(ang), -jnp.sin(ang)], axis=-1)
    freq = freq.astype(F32)
    h = jnp.sin(freq[0] * (z @ w1.astype(F32) + b1.astype(F32)))
    h = jnp.sin(freq[1] * (h @ w2.astype(F32) + b2.astype(F32)))
    h = (h @ w3.astype(F32)).reshape(L, HY_ORDER, 2, HY_WIDTH)
    h = h * jnp.exp(-t[:, :, None, None] * decay.astype(F32)[None])
    hf, hb = h[:, :, 0], h[:, :, 1]
    kc = jnp.concatenate([hf, jnp.zeros((1, HY_ORDER, HY_WIDTH), F32), hb[1:][::-1]], axis=0)
    kc = kc / jnp.sum(jnp.abs(kc), axis=0, keepdims=True)
    return jnp.fft.rfft(kc, axis=0)


def fftconv(u, kf, dbias):
    L = u.shape[1]
    uf = u.astype(F32)
    U = jnp.fft.rfft(uf, n=2 * L, axis=1)
    y = jnp.fft.irfft(U * kf[None], n=2 * L, axis=1)[:, :L]
    return (y + uf * dbias.astype(F32)).astype(u.dtype)


def hyena_mixer(p, conv_w, conv_b, w1, b1, freq, w2, b2, w3, decay, dbias):
    S = p.shape[1]
    u = dwconv3(p, conv_w, conv_b)
    v = u[..., :HY_WIDTH]
    x1 = u[..., HY_WIDTH:2 * HY_WIDTH]
    x2 = u[..., 2 * HY_WIDTH:]
    kf = hyena_filters(S, w1, b1, freq, w2, b2, w3, decay)
    z = x1 * fftconv(v, kf[:, 0], dbias[0])
    return x2 * fftconv(z, kf[:, 1], dbias[1])


def axial_gqa(q, k, v, g_q, g_k):
    B, S, _, E = q.shape
    q = rms_norm(q, g_q)
    k = rms_norm(k, g_k)
    ROWS = S // GRID_W
    rows = jnp.repeat(jnp.arange(ROWS), GRID_W)
    cols = jnp.tile(jnp.arange(GRID_W), ROWS)
    q = axial_rope(q, rows, cols)
    k = axial_rope(k, rows, cols)
    nq = S // Q_BLOCK
    qb = q.reshape(B, nq, Q_BLOCK, C_KV_HEADS, C_GROUP, E).transpose(1, 0, 2, 3, 4, 5)
    scale = E ** -0.5

    def attend(qblk):
        s = jnp.einsum('bqgre,bkge->bgrqk', qblk, k).astype(F32) * scale
        pr = jax.nn.softmax(s, axis=-1)
        return jnp.einsum('bgrqk,bkge->bqgre', pr.astype(v.dtype), v)

    o = lax.map(attend, qb)
    return o.transpose(1, 0, 2, 3, 4, 5).reshape(B, S, C_WIDTH)


def conv_geglu(h, w_gate, w_up, conv_w, conv_b, w_down):
    gate = dwconv3(h @ w_gate, conv_w, conv_b)
    return (jax.nn.gelu(gate, approximate=True) * (h @ w_up)) @ w_down


def setup_inputs(seed: int = 0) -> dict:
    key = jax.random.key(seed)
    ks = jax.random.split(key, 32)

    def nrm(k, shape, scale):
        return jax.random.normal(k, shape, F32) * scale

    def gain(k, shape):
        return 1.0 + 0.05 * jax.random.normal(k, shape, F32)

    L_ = DEPTH
    base_decay = jnp.abs(jnp.linspace(math.log(1e-2) / 1.5, math.log(1e-2) / 0.3, HY_WIDTH, dtype=F32))
    hy_decay = base_decay[None, None, None, :] * (1.0 + 0.05 * jax.random.normal(ks[17], (L_, HY_ORDER, 2, HY_WIDTH), F32))
    return {
        "x": jax.random.normal(ks[0], (BATCH, SEQ, D_MODEL), F32),
        "g_mix_pre": gain(ks[1], (L_, D_MODEL)),
        "g_mix_post": gain(ks[2], (L_, D_MODEL)),
        "g_ffn_pre": gain(ks[3], (L_, D_MODEL)),
        "g_ffn_post": gain(ks[4], (L_, D_MODEL)),
        "w_in": nrm(ks[5], (L_, D_MODEL, PROJ_WIDTH), D_MODEL ** -0.5),
        "w_out": nrm(ks[6], (L_, MIX_WIDTH, D_MODEL), MIX_WIDTH ** -0.5),
        "g_q": gain(ks[7], (L_, HEAD_DIM)),
        "g_k": gain(ks[8], (L_, HEAD_DIM)),
        "hy_conv_w": nrm(ks[9], (L_, 3, (HY_ORDER + 1) * HY_WIDTH), 3 ** -0.5),
        "hy_conv_b": nrm(ks[10], (L_, (HY_ORDER + 1) * HY_WIDTH), 0.02),
        "hy_w1": nrm(ks[11], (L_, HY_EMB, HY_HIDDEN), HY_EMB ** -0.5),
        "hy_b1": nrm(ks[12], (L_, HY_HIDDEN), 0.02),
        "hy_freq": gain(ks[13], (L_, 2, HY_HIDDEN)),
        "hy_w2": nrm(ks[14], (L_, HY_HIDDEN, HY_HIDDEN), HY_HIDDEN ** -0.5),
        "hy_b2": nrm(ks[15], (L_, HY_HIDDEN), 0.02),
        "hy_w3": nrm(ks[16], (L_, HY_HIDDEN, HY_ORDER * 2 * HY_WIDTH), HY_HIDDEN ** -0.5),
        "hy_decay": hy_decay,
        "hy_d": nrm(ks[18], (L_, HY_ORDER, HY_WIDTH), 0.1),
        "ffn_w_gate": nrm(ks[19], (L_, D_MODEL, D_FF), D_MODEL ** -0.5),
        "ffn_w_up": nrm(ks[20], (L_, D_MODEL, D_FF), D_MODEL ** -0.5),
        "ffn_conv_w": nrm(ks[21], (L_, 3, D_FF), 3 ** -0.5),
        "ffn_conv_b": nrm(ks[22], (L_, D_FF), 0.02),
        "ffn_w_down": nrm(ks[23], (L_, D_FF, D_MODEL), D_FF ** -0.5),
    }


def reference(x, g_mix_pre, g_mix_post, g_ffn_pre, g_ffn_post, w_in, w_out, g_q, g_k,
              hy_conv_w, hy_conv_b, hy_w1, hy_b1, hy_freq, hy_w2, hy_b2, hy_w3, hy_decay, hy_d,
              ffn_w_gate, ffn_w_up, ffn_conv_w, ffn_conv_b, ffn_w_down):
    B, S, _ = x.shape
    cos1, sin1 = rope_angles(jnp.arange(S), HEAD_DIM)
    for i in range(DEPTH):
        h = rms_norm(x, g_mix_pre[i])
        p = h @ w_in[i]
        qa = apply_rope(p[..., A_Q0:A_K0].reshape(B, S, A_HEADS, HEAD_DIM), cos1, sin1)
        ka = apply_rope(p[..., A_K0:A_V0].reshape(B, S, A_HEADS, HEAD_DIM), cos1, sin1)
        va = p[..., A_V0:HY_0].reshape(B, S, A_HEADS, HEAD_DIM)
        out_a = dilated_attention(qa, ka, va).reshape(B, S, A_WIDTH)
        out_b = hyena_mixer(p[..., HY_0:C_Q0], hy_conv_w[i], hy_conv_b[i], hy_w1[i], hy_b1[i],
                            hy_freq[i], hy_w2[i], hy_b2[i], hy_w3[i], hy_decay[i], hy_d[i])
        qc = p[..., C_Q0:C_K0].reshape(B, S, C_Q_HEADS, HEAD_DIM)
        kc = p[..., C_K0:C_V0].reshape(B, S, C_KV_HEADS, HEAD_DIM)
        vc = p[..., C_V0:PROJ_WIDTH].reshape(B, S, C_KV_HEADS, HEAD_DIM)
        out_c = axial_gqa(qc, kc, vc, g_q[i], g_k[i])
        mix = jnp.concatenate([out_a, out_b, out_c], axis=-1) @ w_out[i]
        x = x + rms_norm(mix, g_mix_post[i])
        h = rms_norm(x, g_ffn_pre[i])
        f = conv_geglu(h, ffn_w_gate[i], ffn_w_up[i], ffn_conv_w[i], ffn_conv_b[i], ffn_w_down[i])
        x = x + rms_norm(f, g_ffn_post[i])
    return x
```

```cpp
#include <hip/hip_runtime.h>
#include <hip/hip_cooperative_groups.h>
#include <cstdio>
namespace cg = cooperative_groups;

#ifndef NPH
#define NPH 15
#endif
#ifndef REPM
#define REPM 0
#endif
#define NREP(bit) ((REPM & (bit)) ? 2 : 1)
#ifndef MK_COOP
#define MK_COOP 1
#endif

#define LAS __attribute__((address_space(3)))
typedef unsigned short bf16_t;
typedef short bf16x8 __attribute__((ext_vector_type(8)));
typedef short bf16x4 __attribute__((ext_vector_type(4)));
typedef float f32x4 __attribute__((ext_vector_type(4)));
typedef float f32x16 __attribute__((ext_vector_type(16)));
typedef unsigned u32x4 __attribute__((ext_vector_type(4)));
typedef unsigned u32x2 __attribute__((ext_vector_type(2)));

constexpr int NB = 32, SEQ = 2048, DM = 1024, MTOK = NB * SEQ, PW = 2560, FF = 2816;
constexpr int CQ0 = 1920, CK0 = 2304, CV0 = 2432;
constexpr float LOG2E = 1.4426950408889634f;
constexpr float EPS = 1e-6f;

constexpr size_t WS_RAC = 32768;
constexpr size_t WS_RAS = WS_RAC + 2048 * 32 * 4;
constexpr size_t WS_RCC = WS_RAS + 2048 * 32 * 4;
constexpr size_t WS_RCS = WS_RCC + 64 * 16 * 4;
constexpr size_t WS_WIN = WS_RCS + 64 * 16 * 4;
constexpr size_t WS_WOUT = WS_WIN + 2ull * 2560 * 1024 * 2;
constexpr size_t WS_WGU = WS_WOUT + 2ull * 1024 * 1024 * 2;
constexpr size_t WS_WDN = WS_WGU + 2ull * 5632 * 1024 * 2;
constexpr size_t WS_HRAW = WS_WDN + 2ull * 1024 * 2816 * 2;
constexpr size_t WS_H = WS_HRAW + 2ull * 2048 * 1024 * 4;
constexpr size_t WS_P = WS_H + (size_t)MTOK * 1024 * 2;
constexpr size_t WS_MIX = WS_P + (size_t)MTOK * 2816 * 2;
constexpr size_t WS_F = WS_MIX + (size_t)MTOK * 1024 * 2;
constexpr size_t WS_END = WS_F + (size_t)MTOK * 1024 * 4;
constexpr size_t OFF_UC = WS_H, OFF_Z = WS_H + 3ull * 256 * MTOK * 2;
constexpr size_t OFF_UT = WS_F, OFF_OA = WS_F + 768ull * MTOK * 2, OFF_LSE = OFF_OA + 2ull * MTOK * 384 * 2;
constexpr size_t EDGE_SZ = 1024ull * 2 * FF * 4;
constexpr size_t OFF_EP = WS_MIX, OFF_EG = WS_MIX + EDGE_SZ, OFF_EU = WS_MIX + 2 * EDGE_SZ;
constexpr int LDS_BYTES = 163840;

struct Args { const float* in[24]; float* out; unsigned char* ws; int ph_lo, ph_hi, coop, pad; };

__device__ __forceinline__ int tidx() { int t = threadIdx.x; asm volatile("" : "+v"(t)); return t; }
__device__ __forceinline__ unsigned pk2(float lo, float hi) { unsigned r; asm("v_cvt_pk_bf16_f32 %0, %1, %2" : "=v"(r) : "v"(lo), "v"(hi)); return r; }
typedef float f32x2v __attribute__((ext_vector_type(2)));
typedef __bf16 bf16v2 __attribute__((ext_vector_type(2)));
__device__ __forceinline__ unsigned pk2n(float lo, float hi) { const f32x2v v = {lo, hi}; const bf16v2 b = __builtin_convertvector(v, bf16v2); return __builtin_bit_cast(unsigned, b); }
__device__ __forceinline__ float bf2f(bf16_t b) { return __uint_as_float(((unsigned)b) << 16); }
__device__ __forceinline__ float bflo(unsigned w) { return __uint_as_float(w << 16); }
__device__ __forceinline__ float bfhi(unsigned w) { return __uint_as_float(w & 0xffff0000u); }
__device__ __forceinline__ float wave_sum(float v) {
#pragma unroll
    for (int o = 1; o < 64; o <<= 1) v += __shfl_xor(v, o);
    return v;
}
__device__ __forceinline__ float fexp2(float x) { return __builtin_amdgcn_exp2f(x); }
__device__ __forceinline__ float gelu_tanh(float x) {
    const float u = x * (1.0f + 0.044715f * x * x);
    const float e = fexp2(-2.0f * 0.7978845608028654f * LOG2E * u);
    return x * __builtin_amdgcn_rcpf(1.0f + e);
}

namespace pg8 {
constexpr int BM = 256, BK = 64, HALF = 128, HTB = HALF * BK * 2, STAGE_BYTES = 8 * HTB, NXCD = 8, WGM = 8;
__device__ __forceinline__ int lds_byte(int r, int c) { const int st = (r >> 4) * 2 + (c >> 5), rr = r & 15, cc = c & 31, ob = rr * 64 + cc * 2; return st * 1024 + (ob ^ (((ob >> 9) & 1) << 5)); }
__device__ __forceinline__ void stage_rc(int b, int& R, int& C) { const int st = b / 1024, sb = b % 1024, swz = sb ^ (((sb >> 9) & 1) << 5); R = (st >> 1) * 16 + swz / 64; C = (st & 1) * 32 + (swz % 64) / 2; }
struct Unit { int pm, pn; };
struct Gemm { const bf16_t* A; const bf16_t* Bt; int M, N, K; };
struct StaticOrder {
    int nM, nN, nwg, G, c;
    __device__ void init(int M, int N, int G_, int c_) { nM = M / BM; nN = N / BM; nwg = nM * nN; G = G_; c = c_; }
    __device__ __forceinline__ bool next(int i, Unit& u) const {
        const long L = (long)i * G + c; if (L >= nwg) return false;
        int wgid = (int)L; { const int q = nwg / NXCD, r = nwg % NXCD, xcd = wgid % NXCD, off = wgid / NXCD; wgid = (xcd < r ? xcd * (q + 1) : r * (q + 1) + (xcd - r) * q) + off; }
        const int nig = WGM * nN, gid = wgid / nig, fm = gid * WGM, gsz = (nM - fm) < WGM ? (nM - fm) : WGM;
        u.pm = fm + ((wgid % nig) % gsz); u.pn = (wgid % nig) / gsz; return true;
    }
};
struct PanelOrder {
    int pm;
    __device__ __forceinline__ bool next(int i, Unit& u) const { if (i >= 4) return false; u.pm = pm; u.pn = i; return true; }
};

template <class Epi, class Sched>
__device__ __forceinline__ void gemm_phase(LAS unsigned char* lds, const Gemm g, const Sched& S, const Epi& E) {
    const int tid = tidx(), wid = __builtin_amdgcn_readfirstlane(tid >> 6), lane = tid & 63, wr = wid >> 2, wc = wid & 3, fr = lane & 15, fq = lane >> 4;
    const int K = g.K, nt = K / BK;
    unsigned voffA[2], voffB[2];
#pragma unroll
    for (int i = 0; i < 2; ++i) { int R, C; stage_rc(tid * 16 + i * 8192, R, C); voffA[i] = (unsigned)(R * K + C) * 2u; voffB[i] = voffA[i]; }
    const size_t kstep = (size_t)(BK * 2);
    const size_t hstep = (size_t)HALF * K * 2;
    const size_t tstep = 2 * hstep;
    const unsigned ldsw = (unsigned)wid * 1024u;
    const int aoff = lds_byte(wr * 64 + fr, fq * 8), boff = lds_byte(wc * 32 + fr, fq * 8);
#define PG8_SA(b, h) (((b) * 2 + (h)) * HTB)
#define PG8_SB(b, h) ((4 + (b) * 2 + (h)) * HTB)
#define PG8_STAGE(bufoff, gbase, voff) do { _Pragma("unroll") for (int _i = 0; _i < 2; ++_i) \
        __builtin_amdgcn_global_load_lds((const unsigned*)((const char*)(gbase) + (voff)[_i]), (LAS unsigned*)(lds + (bufoff) + ldsw + _i * 8192), 16, 0, 0); } while (0)
#define PG8_LDA(dst, b, h) do { _Pragma("unroll") for (int m = 0; m < 4; ++m) _Pragma("unroll") for (int k = 0; k < 2; ++k) dst[m][k] = *(const LAS bf16x8*)(lds + PG8_SA(b, h) + aoff + m * 2048 + k * 1024); } while (0)
#define PG8_LDB(dst, b, h) do { _Pragma("unroll") for (int n = 0; n < 2; ++n) _Pragma("unroll") for (int k = 0; k < 2; ++k) dst[n][k] = *(const LAS bf16x8*)(lds + PG8_SB(b, h) + boff + n * 2048 + k * 1024); } while (0)
#define PG8_MMA(ai, bj, At, Bt) do { __builtin_amdgcn_s_setprio(1); _Pragma("unroll") for (int m = 0; m < 4; ++m) _Pragma("unroll") for (int n = 0; n < 2; ++n) _Pragma("unroll") for (int k = 0; k < 2; ++k) \
        acc[ai][bj][m][n] = __builtin_amdgcn_mfma_f32_16x16x32_bf16(Bt[n][k], At[m][k], acc[ai][bj][m][n], 0, 0, 0); __builtin_amdgcn_s_setprio(0); } while (0)
#define PG8_WAIT_V(n) asm volatile("s_waitcnt vmcnt(" #n ")" ::: "memory")
#define PG8_WAIT_L(n) asm volatile("s_waitcnt lgkmcnt(" #n ")" ::: "memory")
#define PG8_BAR __builtin_amdgcn_s_barrier()
#define PG8_SCHED __builtin_amdgcn_sched_barrier(0)
    Unit cur, nxt; int ui = 0;
    if (!S.next(0, cur)) return;
    f32x4 acc[2][2][4][2];
#pragma unroll
    for (int a = 0; a < 2; ++a)
#pragma unroll
        for (int b = 0; b < 2; ++b)
#pragma unroll
            for (int m = 0; m < 4; ++m)
#pragma unroll
                for (int n = 0; n < 2; ++n) acc[a][b][m][n] = (f32x4){0.f, 0.f, 0.f, 0.f};
    bf16x8 At[4][2], B0[2][2], B1[2][2];
    const char* cA = (const char*)g.A + (size_t)cur.pm * tstep; const char* cB = (const char*)g.Bt + (size_t)cur.pn * tstep;
    PG8_STAGE(PG8_SB(0, 0), cB, voffB); PG8_STAGE(PG8_SA(0, 0), cA, voffA); PG8_STAGE(PG8_SB(0, 1), cB + hstep, voffB); PG8_STAGE(PG8_SA(0, 1), cA + hstep, voffA);
    if (wr == 1) PG8_BAR;
    PG8_WAIT_V(4); PG8_BAR;
    PG8_STAGE(PG8_SB(1, 0), cB + kstep, voffB); PG8_STAGE(PG8_SA(1, 0), cA + kstep, voffA); PG8_STAGE(PG8_SB(1, 1), cB + hstep + kstep, voffB);
    PG8_WAIT_V(6); PG8_BAR;
    for (;;) {
        const bool has_next = S.next(ui + 1, nxt);
        const char* nA = has_next ? (const char*)g.A + (size_t)nxt.pm * tstep : cA; const char* nB = has_next ? (const char*)g.Bt + (size_t)nxt.pn * tstep : cB;
        for (int t = 0; t < nt; t += 2) {
            const bool last = (t == nt - 2);
            const char* a1 = cA + (size_t)(t + 1) * kstep;
            const char* a2 = last ? nA : cA + (size_t)(t + 2) * kstep; const char* b2 = last ? nB : cB + (size_t)(t + 2) * kstep;
            const char* a3 = a2 + kstep; const char* b3 = b2 + kstep;
            PG8_LDB(B0, 0, 0); PG8_SCHED; PG8_LDA(At, 0, 0); PG8_STAGE(PG8_SA(1, 1), a1 + hstep, voffA);
            PG8_WAIT_L(8); PG8_BAR; PG8_WAIT_L(0); PG8_MMA(0, 0, At, B0); PG8_BAR; PG8_SCHED;
            PG8_LDB(B1, 0, 1); PG8_STAGE(PG8_SB(0, 0), b2, voffB);
            PG8_BAR; PG8_WAIT_L(0); PG8_MMA(0, 1, At, B1); PG8_BAR;
            PG8_LDA(At, 0, 1); PG8_STAGE(PG8_SA(0, 0), a2, voffA);
            PG8_BAR; PG8_WAIT_L(0); PG8_MMA(1, 0, At, B0); PG8_BAR; PG8_SCHED;
            PG8_STAGE(PG8_SB(0, 1), b2 + hstep, voffB);
            PG8_WAIT_V(6); PG8_BAR; PG8_MMA(1, 1, At, B1); PG8_BAR;
            PG8_LDB(B0, 1, 0); PG8_SCHED; PG8_LDA(At, 1, 0); PG8_STAGE(PG8_SA(0, 1), a2 + hstep, voffA);
            PG8_WAIT_L(8); PG8_BAR; PG8_WAIT_L(0); PG8_MMA(0, 0, At, B0); PG8_BAR; PG8_SCHED;
            PG8_LDB(B1, 1, 1); PG8_STAGE(PG8_SB(1, 0), b3, voffB);
            PG8_BAR; PG8_WAIT_L(0); PG8_MMA(0, 1, At, B1); PG8_BAR;
            PG8_LDA(At, 1, 1); PG8_STAGE(PG8_SA(1, 0), a3, voffA);
            PG8_BAR; PG8_WAIT_L(0); PG8_MMA(1, 0, At, B0); PG8_BAR; PG8_SCHED;
            PG8_STAGE(PG8_SB(1, 1), b3 + hstep, voffB);
            PG8_WAIT_V(6); PG8_BAR; PG8_MMA(1, 1, At, B1); PG8_BAR;
        }
        E(acc, cur, wr, wc, fr, fq);
        if (!has_next) break;
#pragma unroll
        for (int a = 0; a < 2; ++a)
#pragma unroll
            for (int b = 0; b < 2; ++b)
#pragma unroll
                for (int m = 0; m < 4; ++m)
#pragma unroll
                    for (int n = 0; n < 2; ++n) acc[a][b][m][n] = (f32x4){0.f, 0.f, 0.f, 0.f};
        cur = nxt; cA = nA; cB = nB; ++ui;
    }
    PG8_WAIT_V(0);
    if (wr == 0) PG8_BAR;
    PG8_BAR;
#undef PG8_SA
#undef PG8_SB
#undef PG8_STAGE
#undef PG8_LDA
#undef PG8_LDB
#undef PG8_MMA
#undef PG8_WAIT_V
#undef PG8_WAIT_L
#undef PG8_BAR
#undef PG8_SCHED
}
}
using pg8::Unit;

struct EpiIn {
    bf16_t* P; bf16_t* UT; const float* rac; const float* ras; const float* rcc; const float* rcs; const float* gq; const float* gk; LAS unsigned char* scr;
    __device__ __forceinline__ void operator()(const f32x4 (&acc)[2][2][4][2], const Unit& uu, int wr, int wc, int fr, int fq) const {
        Unit u = uu; asm volatile("" : "+s"(u.pm), "+s"(u.pn), "+v"(fr), "+v"(fq));
        const int ch = 4 * u.pn + wc;
        const int rowb = u.pm * 256 + wr * 64 + fr;
        if (ch < 12) {
            const float qs = (ch < 6) ? 0.125f * LOG2E : 1.0f;
#pragma unroll
            for (int ai = 0; ai < 2; ++ai)
#pragma unroll
                for (int m = 0; m < 4; ++m) {
                    const int r = rowb + 128 * ai + 16 * m, s = r & 2047;
                    u32x4 w1, w2;
                    {
                        const f32x4 c0 = *(const f32x4*)(rac + s * 32 + 8 * fq), s0 = *(const f32x4*)(ras + s * 32 + 8 * fq);
                        const f32x4 c1 = *(const f32x4*)(rac + s * 32 + 8 * fq + 4), s1 = *(const f32x4*)(ras + s * 32 + 8 * fq + 4);
                        const f32x4 x10 = acc[ai][0][m][0], x11 = acc[ai][0][m][1], x20 = acc[ai][1][m][0], x21 = acc[ai][1][m][1];
                        const f32x4 a0 = (x10 * c0 - x20 * s0) * qs, a1 = (x11 * c1 - x21 * s1) * qs;
                        const f32x4 b0 = (x20 * c0 + x10 * s0) * qs, b1 = (x21 * c1 + x11 * s1) * qs;
                        w1.x = pk2(a0[0], a0[1]); w1.y = pk2(a0[2], a0[3]); w1.z = pk2(a1[0], a1[1]); w1.w = pk2(a1[2], a1[3]);
                        w2.x = pk2(b0[0], b0[1]); w2.y = pk2(b0[2], b0[3]); w2.z = pk2(b1[0], b1[1]); w2.w = pk2(b1[2], b1[3]);
                    }
                    bf16_t* dst = P + (size_t)r * PW + 64 * ch + 8 * fq;
                    *(u32x4*)dst = w1; *(u32x4*)(dst + 32) = w2;
                }
        } else if (ch < 18 || ch >= 38) {
#pragma unroll
            for (int ai = 0; ai < 2; ++ai)
#pragma unroll
                for (int m = 0; m < 4; ++m) {
                    const int r = rowb + 128 * ai + 16 * m;
                    bf16_t* dst = P + (size_t)r * PW + 64 * ch + 8 * fq;
#pragma unroll
                    for (int bj = 0; bj < 2; ++bj) {
                        const f32x4 v0 = acc[ai][bj][m][0], v1 = acc[ai][bj][m][1];
                        u32x4 w; w.x = pk2(v0[0], v0[1]); w.y = pk2(v0[2], v0[3]); w.z = pk2(v1[0], v1[1]); w.w = pk2(v1[2], v1[3]);
                        *(u32x4*)(dst + 32 * bj) = w;
                    }
                }
        } else if (ch < 30) {
            const int wid = wr * 4 + wc, lane = fq * 16 + fr;
            LAS unsigned char* T = scr + wid * 4096;
#pragma unroll
            for (int ai = 0; ai < 2; ++ai)
#pragma unroll
                for (int bj = 0; bj < 2; ++bj) {
#pragma unroll
                    for (int m = 0; m < 4; ++m)
#pragma unroll
                        for (int n = 0; n < 2; ++n)
#pragma unroll
                            for (int j = 0; j < 4; ++j) {
                                const int chl = 8 * fq + 4 * n + j, rl = 16 * m + fr;
                                *(LAS bf16_t*)(T + chl * 128 + rl * 2) = (bf16_t)(pk2(acc[ai][bj][m][n][j], 0.f) & 0xffffu);
                            }
                    asm volatile("s_waitcnt lgkmcnt(0)" ::: "memory");
                    const int r0 = u.pm * 256 + 128 * ai + 64 * wr;
                    const int hc0 = 64 * (ch - 18) + 32 * bj;
#pragma unroll
                    for (int q = 0; q < 4; ++q) {
                        const int idx = q * 64 + lane, chl = idx >> 3, k = idx & 7;
                        const u32x4 v = *(const LAS u32x4*)(T + chl * 128 + k * 16);
                        *(u32x4*)(UT + (size_t)(hc0 + chl) * MTOK + r0 + 8 * k) = v;
                    }
                    asm volatile("s_waitcnt lgkmcnt(0)" ::: "memory");
                }
        } else {
            const float* g = (ch < 36) ? gq : gk;
            const float qs = (ch < 36) ? 0.125f * LOG2E : 1.0f;
            f32x4 g4[2][2];
#pragma unroll
            for (int bj = 0; bj < 2; ++bj)
#pragma unroll
                for (int n = 0; n < 2; ++n) g4[bj][n] = *(const f32x4*)(g + 32 * bj + 16 * n + 4 * fq);
#pragma unroll
            for (int ai = 0; ai < 2; ++ai)
#pragma unroll
                for (int m = 0; m < 4; ++m) {
                    const int r = rowb + 128 * ai + 16 * m, s = r & 2047;
                    float ss = 0.f;
#pragma unroll
                    for (int bj = 0; bj < 2; ++bj)
#pragma unroll
                        for (int n = 0; n < 2; ++n) { const f32x4 x = acc[ai][bj][m][n]; ss += (x[0] * x[0] + x[1] * x[1]) + (x[2] * x[2] + x[3] * x[3]); }
                    ss += __shfl_xor(ss, 16); ss += __shfl_xor(ss, 32);
                    const float rstd = rsqrtf(ss * (1.0f / 64.0f) + EPS) * qs;
                    bf16_t* dst = P + (size_t)r * PW + 64 * ch + 8 * fq;
#pragma unroll
                    for (int bj = 0; bj < 2; ++bj) {
                        const int pos = bj ? (s & 63) : (s >> 6);
                        const f32x4 c = *(const f32x4*)(rcc + pos * 16 + 4 * fq), sn = *(const f32x4*)(rcs + pos * 16 + 4 * fq);
                        const f32x4 x1 = acc[ai][bj][m][0] * g4[bj][0] * rstd, x2 = acc[ai][bj][m][1] * g4[bj][1] * rstd;
                        const f32x4 o1 = x1 * c - x2 * sn, o2 = x2 * c + x1 * sn;
                        u32x4 w; w.x = pk2(o1[0], o1[1]); w.y = pk2(o1[2], o1[3]); w.z = pk2(o2[0], o2[1]); w.w = pk2(o2[2], o2[3]);
                        *(u32x4*)(dst + 32 * bj) = w;
                    }
                }
        }
    }
};

struct EpiF {
    bf16_t* F;
    __device__ __forceinline__ void operator()(const f32x4 (&acc)[2][2][4][2], const Unit& uu, int wr, int wc, int fr, int fq) const {
        Unit u = uu; asm volatile("" : "+s"(u.pm), "+s"(u.pn), "+v"(fr), "+v"(fq));
        const int row0 = u.pm * 256 + wr * 64 + fr, col0 = u.pn * 256 + wc * 32 + 8 * fq;
#pragma unroll
        for (int ai = 0; ai < 2; ++ai)
#pragma unroll
            for (int m = 0; m < 4; ++m) {
                bf16_t* rowp = F + (size_t)(row0 + ai * 128 + m * 16) * DM + col0;
#pragma unroll
                for (int bj = 0; bj < 2; ++bj) {
                    const f32x4 v0 = acc[ai][bj][m][0], v1 = acc[ai][bj][m][1];
                    u32x4 w; w.x = pk2(v0[0], v0[1]); w.y = pk2(v0[2], v0[3]); w.z = pk2(v1[0], v1[1]); w.w = pk2(v1[2], v1[3]);
                    *(u32x4*)(rowp + bj * 128) = w;
                }
            }
    }
};

struct EpiGU {
    bf16_t* ACT; float* EP; float* EG; float* EU; const float* cw; const float* cb;
    __device__ __forceinline__ void operator()(const f32x4 (&acc)[2][2][4][2], const Unit& uu, int wr, int wc, int fr, int fq) const {
        Unit u = uu; asm volatile("" : "+s"(u.pm), "+s"(u.pn), "+v"(fr), "+v"(fq));
        const int chan0 = 128 * u.pn + 32 * wc + 8 * fq;
        const int lane = fq * 16 + fr;
        const int srcU = (lane & 48) | ((fr + 15) & 15), srcD = (lane & 48) | ((fr + 1) & 15);
#pragma unroll
        for (int ai = 0; ai < 2; ++ai) {
            const int Rg = u.pm * 256 + 128 * ai + 64 * wr;
            const int gi = Rg >> 6;
#pragma unroll
            for (int n = 0; n < 2; ++n) {
                const f32x4 w0 = *(const f32x4*)(cw + chan0 + 4 * n), w1 = *(const f32x4*)(cw + FF + chan0 + 4 * n), w2 = *(const f32x4*)(cw + 2 * FF + chan0 + 4 * n), bb = *(const f32x4*)(cb + chan0 + 4 * n);
                f32x4 av[4], ptop, pbot;
#pragma unroll
                for (int j = 0; j < 4; ++j) {
                    float gv[4], ru[4], rd[4];
#pragma unroll
                    for (int m = 0; m < 4; ++m) { gv[m] = acc[ai][0][m][n][j]; ru[m] = __shfl(gv[m], srcU); rd[m] = __shfl(gv[m], srcD); }
#pragma unroll
                    for (int m = 0; m < 4; ++m) {
                        const float prev = (fr == 0) ? (m > 0 ? ru[m > 0 ? m - 1 : 0] : 0.f) : ru[m];
                        const float next = (fr == 15) ? (m < 3 ? rd[m < 3 ? m + 1 : 3] : 0.f) : rd[m];
                        const float pre = w0[j] * prev + w1[j] * gv[m] + w2[j] * next + bb[j];
                        av[m][j] = gelu_tanh(pre) * acc[ai][1][m][n][j];
                        if (m == 0) ptop[j] = pre;
                        if (m == 3) pbot[j] = pre;
                    }
                }
                if (fr == 0) { const size_t eo = ((size_t)gi * 2) * FF + chan0 + 4 * n; *(f32x4*)(EP + eo) = ptop; *(f32x4*)(EG + eo) = acc[ai][0][0][n]; *(f32x4*)(EU + eo) = acc[ai][1][0][n]; }
                if (fr == 15) { const size_t eo = ((size_t)gi * 2 + 1) * FF + chan0 + 4 * n; *(f32x4*)(EP + eo) = pbot; *(f32x4*)(EG + eo) = acc[ai][0][3][n]; *(f32x4*)(EU + eo) = acc[ai][1][3][n]; }
#pragma unroll
                for (int m = 0; m < 4; ++m) {
                    const bool edge = ((m == 0) && (fr == 0)) || ((m == 3) && (fr == 15));
                    if (!edge) { u32x2 w; w.x = pk2(av[m][0], av[m][1]); w.y = pk2(av[m][2], av[m][3]); *(u32x2*)(ACT + (size_t)(Rg + 16 * m + fr) * FF + chan0 + 4 * n) = w; }
                }
            }
        }
    }
};

__device__ __forceinline__ int colmap_in(int R) {
    const int T = R >> 8, rt = R & 255, bj = rt >> 7, wc = (rt >> 5) & 3, n = (rt >> 4) & 1, fq = (rt >> 2) & 3, j = rt & 3;
    const int ch = 4 * T + wc;
    const int l = (ch >= 30 && ch < 38) ? (32 * bj + 16 * n + 4 * fq + j) : (32 * bj + 8 * fq + 4 * n + j);
    return 64 * ch + l;
}
template <int MODE>
__device__ __forceinline__ void transpose_item(const Args& a, int layer, int item, LAS float* scr, int lane) {
    constexpr int K = (MODE == 3) ? FF : DM;
    constexpr int NP = (MODE == 0) ? PW : (MODE == 2 ? 2 * FF : DM);
    constexpr int N = (MODE == 0) ? PW : (MODE == 2 ? FF : DM);
    const int nblk = NP / 32, kb = item / nblk, nb = item % nblk, k0 = 64 * kb, n0 = 32 * nb;
    const int R = n0 + (lane & 31);
    const float* src; int col;
    if (MODE == 0) { src = a.in[5] + (size_t)layer * DM * PW; col = colmap_in(R); }
    else if (MODE == 1) { src = a.in[6] + (size_t)layer * DM * DM; col = (R & ~31) + 8 * ((R >> 2) & 3) + 4 * ((R >> 4) & 1) + (R & 3); }
    else if (MODE == 2) {
        const int T = R >> 8, rt = R & 255, bj = rt >> 7, wc = (rt >> 5) & 3, n = (rt >> 4) & 1, fq = (rt >> 2) & 3, j = rt & 3;
        col = 128 * T + 32 * wc + 8 * fq + 4 * n + j; src = (bj ? a.in[20] : a.in[19]) + (size_t)layer * DM * FF;
    } else { src = a.in[23] + (size_t)layer * FF * DM; col = (R & ~31) + 8 * ((R >> 2) & 3) + 4 * ((R >> 4) & 1) + (R & 3); }
    bf16_t* WT = (bf16_t*)(a.ws + (MODE == 0 ? WS_WIN : MODE == 1 ? WS_WOUT : MODE == 2 ? WS_WGU : WS_WDN)) + (size_t)layer * NP * K;
#pragma unroll 8
    for (int i = 0; i < 32; ++i) { const int kk = 2 * i + (lane >> 5); scr[kk * 33 + (lane & 31)] = src[(size_t)(k0 + kk) * N + col]; }
    asm volatile("s_waitcnt lgkmcnt(0)" ::: "memory");
    const int c = lane & 7;
#pragma unroll
    for (int j = 0; j < 4; ++j) {
        const int n = (lane >> 3) + 8 * j; const LAS float* s = scr + (8 * c) * 33 + n;
        u32x4 o; o.x = pk2(s[0 * 33], s[1 * 33]); o.y = pk2(s[2 * 33], s[3 * 33]); o.z = pk2(s[4 * 33], s[5 * 33]); o.w = pk2(s[6 * 33], s[7 * 33]);
        *(u32x4*)(WT + (size_t)(n0 + n) * K + k0 + 8 * c) = o;
    }
    asm volatile("s_waitcnt lgkmcnt(0)" ::: "memory");
}

__device__ __forceinline__ void norm_row(const float* xrow, const float* g, bf16_t* orow, int lane) {
    f32x4 v[4]; float s = 0.f;
#pragma unroll
    for (int j = 0; j < 4; ++j) { v[j] = *(const f32x4*)(xrow + 4 * lane + 256 * j); s += (v[j][0] * v[j][0] + v[j][1] * v[j][1]) + (v[j][2] * v[j][2] + v[j][3] * v[j][3]); }
    const float rstd = rsqrtf(wave_sum(s) * (1.0f / DM) + EPS);
#pragma unroll
    for (int j = 0; j < 4; ++j) {
        const f32x4 gg = *(const f32x4*)(g + 4 * lane + 256 * j); const f32x4 y = v[j] * rstd * gg;
        u32x2 w; w.x = pk2(y[0], y[1]); w.y = pk2(y[2], y[3]); *(u32x2*)(orow + 4 * lane + 256 * j) = w;
    }
}

__device__ __forceinline__ void hyena_raw(const Args& a, int L, int t, LAS float* scr, int lane) {
    const float tl = (float)t * (1.0f / 2047.0f);
    if (lane < 33) {
        float z;
        if (lane == 0) z = tl;
        else {
            const int k = (lane - 1) & 15;
            const float band = 1e-4f + (float)k * ((15.0f - 1e-4f) / 15.0f);
            const float ang = 2.0f * 3.14159265358979323846f * band * (float)t / 2048.0f;
            z = (lane <= 16) ? cosf(ang) : -sinf(ang);
        }
        scr[lane] = z;
    }
    asm volatile("s_waitcnt lgkmcnt(0)" ::: "memory");
    const float* w1 = a.in[11] + L * 33 * 64; const float* b1 = a.in[12] + L * 64; const float* fr = a.in[13] + L * 128;
    const float* w2 = a.in[14] + L * 64 * 64; const float* b2 = a.in[15] + L * 64; const float* w3 = a.in[16] + (size_t)L * 64 * 1024; const float* dec = a.in[17] + L * 1024;
    float h = b1[lane];
    {
        float wv[33];
#pragma unroll
        for (int j = 0; j < 33; ++j) wv[j] = w1[j * 64 + lane];
#pragma unroll
        for (int j = 0; j < 33; ++j) h += scr[j] * wv[j];
    }
    h = sinf(fr[lane] * h);
    scr[64 + lane] = h;
    asm volatile("s_waitcnt lgkmcnt(0)" ::: "memory");
    float h2 = b2[lane];
#pragma unroll 1
    for (int k0 = 0; k0 < 64; k0 += 32) {
        float wv[32];
#pragma unroll
        for (int k = 0; k < 32; ++k) wv[k] = w2[(k0 + k) * 64 + lane];
#pragma unroll
        for (int k = 0; k < 32; ++k) h2 += scr[64 + k0 + k] * wv[k];
    }
    h2 = sinf(fr[64 + lane] * h2);
    scr[128 + lane] = h2;
    asm volatile("s_waitcnt lgkmcnt(0)" ::: "memory");
    float* raw = (float*)(a.ws + WS_HRAW) + ((size_t)L * 2048 + t) * 1024;
    float o[16];
#pragma unroll
    for (int mth = 0; mth < 16; ++mth) o[mth] = 0.f;
#pragma unroll 1
    for (int k0 = 0; k0 < 64; k0 += 4) {
        float wv[4][16];
#pragma unroll
        for (int k = 0; k < 4; ++k)
#pragma unroll
            for (int mth = 0; mth < 16; ++mth) wv[k][mth] = w3[(k0 + k) * 1024 + lane + 64 * mth];
#pragma unroll
        for (int k = 0; k < 4; ++k) { const float hk = scr[128 + k0 + k];
#pragma unroll
            for (int mth = 0; mth < 16; ++mth) o[mth] += hk * wv[k][mth]; }
    }
#pragma unroll
    for (int mth = 0; mth < 16; ++mth) { const int idx = lane + 64 * mth; raw[idx] = o[mth] * expf(-tl * dec[idx]); }
    asm volatile("s_waitcnt lgkmcnt(0)" ::: "memory");
}

__device__ __forceinline__ void phase0(const Args& a, LAS unsigned char* lds) {
    const int tid = tidx(), wid = tid >> 6, lane = tid & 63;
    const int gw = blockIdx.x * 8 + wid, NGW = gridDim.x * 8;
    LAS float* scr = (LAS float*)(lds + wid * 16384);
    for (int i = blockIdx.x * 512 + tid; i < 2048 * 32 + 64 * 16; i += gridDim.x * 512) {
        if (i < 2048 * 32) {
            const int s = i >> 5, d = i & 31; const double f = pow(10000.0, -(double)d / 32.0), ang = (double)s * f;
            ((float*)(a.ws + WS_RAC))[i] = (float)cos(ang); ((float*)(a.ws + WS_RAS))[i] = (float)sin(ang);
        } else {
            const int k = i - 2048 * 32, p = k >> 4, d = k & 15; const double f = pow(10000.0, -(double)d / 16.0), ang = (double)p * f;
            ((float*)(a.ws + WS_RCC))[k] = (float)cos(ang); ((float*)(a.ws + WS_RCS))[k] = (float)sin(ang);
        }
    }
    constexpr int I0 = 16 * 80, I1 = 16 * 32, I2 = 16 * 176, I3 = 44 * 32, IL = I0 + I1 + I2 + I3;
    for (int it = gw; it < 2 * IL; it += NGW) {
        const int layer = it / IL; int r = it % IL;
        if (r < I0) { transpose_item<0>(a, layer, r, scr, lane); continue; } r -= I0;
        if (r < I1) { transpose_item<1>(a, layer, r, scr, lane); continue; } r -= I1;
        if (r < I2) { transpose_item<2>(a, layer, r, scr, lane); continue; } r -= I2;
        transpose_item<3>(a, layer, r, scr, lane);
    }
    for (int it = gw; it < 2 * 2048; it += NGW) hyena_raw(a, it >> 11, it & 2047, scr, lane);
    for (int r = gw * 32; r < MTOK; r += NGW * 32) {
#pragma unroll 1
        for (int k = 0; k < 32; k += 4) {
            f32x4 v[4][4];
#pragma unroll
            for (int u = 0; u < 4; ++u)
#pragma unroll
                for (int j = 0; j < 4; ++j) v[u][j] = *(const f32x4*)(a.in[0] + (size_t)(r + k + u) * DM + 4 * lane + 256 * j);
#pragma unroll
            for (int u = 0; u < 4; ++u) {
                float s = 0.f;
#pragma unroll
                for (int j = 0; j < 4; ++j) s += (v[u][j][0] * v[u][j][0] + v[u][j][1] * v[u][j][1]) + (v[u][j][2] * v[u][j][2] + v[u][j][3] * v[u][j][3]);
                const float rstd = rsqrtf(wave_sum(s) * (1.0f / DM) + EPS);
                bf16_t* orow = (bf16_t*)(a.ws + WS_H) + (size_t)(r + k + u) * DM;
#pragma unroll
                for (int j = 0; j < 4; ++j) { const f32x4 gg = *(const f32x4*)(a.in[1] + 4 * lane + 256 * j); const f32x4 y = v[u][j] * rstd * gg; u32x2 w; w.x = pk2(y[0], y[1]); w.y = pk2(y[2], y[3]); *(u32x2*)(orow + 4 * lane + 256 * j) = w; }
            }
        }
    }
}

__device__ __forceinline__ void gload32(u32x4 (&r)[4], const unsigned char* ubase, unsigned pitch, int lane) {
#pragma unroll
    for (int i = 0; i < 4; ++i) { const unsigned rr = (unsigned)(lane >> 3) + 8u * i; r[i] = *(const u32x4*)(ubase + rr * pitch + (unsigned)(lane & 7) * 16u); }
}
template <bool SWZ>
__device__ __forceinline__ void lwrite32(LAS unsigned char* dst, const u32x4 (&r)[4], int lane) {
#pragma unroll
    for (int i = 0; i < 4; ++i) { const int rr = (lane >> 3) + 8 * i; const int pc = SWZ ? ((lane & 7) ^ ((rr >> 1) & 7)) : (lane & 7); *(LAS u32x4*)(dst + rr * 128 + pc * 16) = r[i]; }
}
__device__ __forceinline__ void load_kf(LAS const unsigned char* kb, bf16x8 (&kf)[4], int lane) {
    const int kl = lane & 31, h = lane >> 5;
#pragma unroll
    for (int s = 0; s < 4; ++s) { const int pc = (2 * s + h) ^ ((kl >> 1) & 7); kf[s] = *(const LAS bf16x8*)(kb + kl * 128 + pc * 16); }
}
__device__ __forceinline__ void load_vf(LAS const unsigned char* vb, bf16x8 (&vf)[2][2], int lane) {
    const int h = lane >> 5, i16 = lane & 15, q = i16 >> 2, p = i16 & 3, dbase = ((lane >> 4) & 1) * 16;
#pragma unroll
    for (int s2 = 0; s2 < 2; ++s2)
#pragma unroll
        for (int dt = 0; dt < 2; ++dt) {
            const int key = 16 * s2 + 4 * h + q, d0 = 32 * dt + dbase + 4 * p;
            const bf16x4 lo = __builtin_amdgcn_ds_read_tr16_b64_v4i16((LAS bf16x4*)(vb + key * 128 + d0 * 2));
            const bf16x4 hi = __builtin_amdgcn_ds_read_tr16_b64_v4i16((LAS bf16x4*)(vb + (key + 8) * 128 + d0 * 2));
            vf[s2][dt] = (bf16x8){lo[0], lo[1], lo[2], lo[3], hi[0], hi[1], hi[2], hi[3]};
        }
}
template <bool KLDS>
__device__ __forceinline__ void attn_step(const bf16x8 (&kf)[4], LAS const unsigned char* kb, const bf16x8 (&vf)[2][2], const bf16x8 (&qf)[4], f32x16& o0, f32x16& o1, float& m, float& l, int lane, int maskmode) {
    const int ql = lane & 31, h = lane >> 5;
    f32x16 S;
#pragma unroll
    for (int i = 0; i < 16; ++i) S[i] = 0.f;
#pragma unroll
    for (int s = 0; s < 4; ++s) {
        if (KLDS) { const int pc = (2 * s + h) ^ ((ql >> 1) & 7); const bf16x8 k1 = *(const LAS bf16x8*)(kb + ql * 128 + pc * 16); S = __builtin_amdgcn_mfma_f32_32x32x16_bf16(k1, qf[s], S, 0, 0, 0); }
        else S = __builtin_amdgcn_mfma_f32_32x32x16_bf16(kf[s], qf[s], S, 0, 0, 0);
    }
    if (maskmode) {
#pragma unroll
        for (int i = 0; i < 16; ++i) { const int kr = (i & 3) + 8 * (i >> 2) + 4 * h; const bool ok = (maskmode == 1) ? (kr >= ql) : (kr <= ql); S[i] = ok ? S[i] : -1e30f; }
    }
    float tm = S[0];
#pragma unroll
    for (int i = 1; i < 16; ++i) tm = fmaxf(tm, S[i]);
    tm = fmaxf(tm, __shfl_xor(tm, 32));
    const float mn = fmaxf(m, tm), al = fexp2(m - mn); m = mn;
    float ps = 0.f;
#pragma unroll
    for (int i = 0; i < 16; ++i) { S[i] = fexp2(S[i] - mn); ps += S[i]; }
    l = l * al + ps;
#pragma unroll
    for (int i = 0; i < 16; ++i) { o0[i] *= al; o1[i] *= al; }
    bf16x8 pf[2];
#pragma unroll
    for (int s2 = 0; s2 < 2; ++s2) {
        u32x4 w; w.x = pk2n(S[8 * s2 + 0], S[8 * s2 + 1]); w.y = pk2n(S[8 * s2 + 2], S[8 * s2 + 3]); w.z = pk2n(S[8 * s2 + 4], S[8 * s2 + 5]); w.w = pk2n(S[8 * s2 + 6], S[8 * s2 + 7]);
        pf[s2] = __builtin_bit_cast(bf16x8, w);
    }
#pragma unroll
    for (int s2 = 0; s2 < 2; ++s2) {
        o0 = __builtin_amdgcn_mfma_f32_32x32x16_bf16(vf[s2][0], pf[s2], o0, 0, 0, 0);
        o1 = __builtin_amdgcn_mfma_f32_32x32x16_bf16(vf[s2][1], pf[s2], o1, 0, 0, 0);
    }
}

__device__ __forceinline__ void attnA_unit(const Args& a, int unit, LAS unsigned char* lds) {
    const int tid = tidx(), wid = __builtin_amdgcn_readfirstlane(tid >> 6), lane = tid & 63, ql = lane & 31, h = lane >> 5;
    const int b = unit / 24, rem = unit % 24, hh = rem >> 2, blk = rem & 3;
    const bf16_t* P = (const bf16_t*)(a.ws + WS_P);
    bf16_t* OA = (bf16_t*)(a.ws + OFF_OA); float* LSE = (float*)(a.ws + OFF_LSE); bf16_t* MIX = (bf16_t*)(a.ws + WS_MIX);
    LAS unsigned char* wl = lds + wid * 8192;
    const unsigned char* kbase = (const unsigned char*)(P + (size_t)b * SEQ * PW + 384 + 64 * hh);
    const unsigned char* vbase = (const unsigned char*)(P + (size_t)b * SEQ * PW + 768 + 64 * hh);
#pragma unroll 1
    for (int pidx = 0; pidx < 3; ++pidx) {
        const int dl = (pidx == 0) ? 1 : (pidx == 1 ? 4 : 16), Ls = SEQ / dl;
        if (pidx == 2) { __syncthreads(); }
#pragma unroll 1
        for (int e = 0; e < 2; ++e) {
            const int qt = 2 * wid + e, r = qt % dl, i0 = (512 * blk) / dl + 32 * (qt / dl);
            const int tq = dl * (i0 + ql) + r;
            bf16x8 qf[4];
            { const bf16_t* qp = P + ((size_t)b * SEQ + tq) * PW + 64 * hh + 8 * h;
#pragma unroll
              for (int s = 0; s < 4; ++s) qf[s] = *(const bf16x8*)(qp + 16 * s); }
            f32x16 o0, o1;
#pragma unroll
            for (int i = 0; i < 16; ++i) { o0[i] = 0.f; o1[i] = 0.f; }
            float m = -1e30f, l = 0.f;
            int kt0 = 0, kt1 = 4;
            if (i0 - 64 < 0) kt0 = (i0 - 32 < 0) ? 2 : 1;
            if (i0 + 64 >= Ls) kt1 = (i0 + 32 >= Ls) ? 2 : 3;
            const unsigned pitch = (unsigned)dl * (PW * 2);
            u32x4 pk[4], pv[4];
            { const size_t ro = (size_t)(dl * (i0 - 64 + 32 * kt0) + r) * (PW * 2); gload32(pk, kbase + ro, pitch, lane); gload32(pv, vbase + ro, pitch, lane); }
#pragma unroll 1
            for (int kt = kt0; kt <= kt1; ++kt) {
                asm volatile("" ::: "memory");
                lwrite32<true>(wl, pk, lane); lwrite32<false>(wl + 4096, pv, lane);
                if (kt < kt1) { const size_t ro = (size_t)(dl * (i0 - 64 + 32 * (kt + 1)) + r) * (PW * 2); gload32(pk, kbase + ro, pitch, lane); gload32(pv, vbase + ro, pitch, lane); }
                asm volatile("s_waitcnt lgkmcnt(0)" ::: "memory");
                bf16x8 kf[4], vf[2][2];
                load_kf(wl, kf, lane); load_vf(wl + 4096, vf, lane);
                attn_step<false>(kf, wl, vf, qf, o0, o1, m, l, lane, kt == 0 ? 1 : (kt == 4 ? 2 : 0));
                asm volatile("" ::: "memory");
            }
            const float lt = l + __shfl_xor(l, 32);
            const float inv = 1.0f / lt, lse = m + __builtin_amdgcn_logf(lt);
            const size_t tokg = (size_t)b * SEQ + tq;
            if (pidx < 2) {
                bf16_t* op = OA + ((size_t)pidx * MTOK + tokg) * 384 + 64 * hh;
#pragma unroll
                for (int dt = 0; dt < 2; ++dt)
#pragma unroll
                    for (int g = 0; g < 4; ++g) {
                        const f32x16& o = dt ? o1 : o0;
                        u32x2 w; w.x = pk2(o[4 * g] * inv, o[4 * g + 1] * inv); w.y = pk2(o[4 * g + 2] * inv, o[4 * g + 3] * inv);
                        *(u32x2*)(op + 32 * dt + 8 * g + 4 * h) = w;
                    }
                if (h == 0) LSE[((size_t)pidx * MTOK + tokg) * 6 + hh] = lse;
            } else {
                const float l1 = LSE[tokg * 6 + hh], l2 = LSE[((size_t)MTOK + tokg) * 6 + hh];
                const float mx = fmaxf(lse, fmaxf(l1, l2));
                const float w1 = fexp2(l1 - mx), w2 = fexp2(l2 - mx), w3 = fexp2(lse - mx);
                const float wi = 1.0f / (w1 + w2 + w3);
                const float c1 = w1 * wi, c2 = w2 * wi, c3 = w3 * wi * inv;
                const bf16_t* p1 = OA + tokg * 384 + 64 * hh; const bf16_t* p2 = OA + ((size_t)MTOK + tokg) * 384 + 64 * hh;
                bf16_t* op = MIX + tokg * DM + 64 * hh;
#pragma unroll
                for (int dt = 0; dt < 2; ++dt)
#pragma unroll
                    for (int g = 0; g < 4; ++g) {
                        const f32x16& o = dt ? o1 : o0;
                        const int d = 32 * dt + 8 * g + 4 * h;
                        const u32x2 a1 = *(const u32x2*)(p1 + d), a2 = *(const u32x2*)(p2 + d);
                        const float r0 = c1 * bflo(a1.x) + c2 * bflo(a2.x) + c3 * o[4 * g], r1 = c1 * bfhi(a1.x) + c2 * bfhi(a2.x) + c3 * o[4 * g + 1];
                        const float r2 = c1 * bflo(a1.y) + c2 * bflo(a2.y) + c3 * o[4 * g + 2], r3 = c1 * bfhi(a1.y) + c2 * bfhi(a2.y) + c3 * o[4 * g + 3];
                        u32x2 w; w.x = pk2(r0, r1); w.y = pk2(r2, r3);
                        *(u32x2*)(op + d) = w;
                    }
            }
        }
    }
}

__device__ __forceinline__ void attnC_unit(const Args& a, int unit, LAS unsigned char* lds) {
    const int tid = tidx(), wid = __builtin_amdgcn_readfirstlane(tid >> 6), lane = tid & 63, ql = lane & 31, h = lane >> 5;
    const int b = unit / 48, rem = unit % 48, hq = rem >> 3, qb = rem & 7, g = hq / 3;
    const int tq = 256 * qb + 32 * wid + ql;
    const bf16_t* P = (const bf16_t*)(a.ws + WS_P);
    bf16_t* MIX = (bf16_t*)(a.ws + WS_MIX);
    const int srow = tid >> 3, sch = tid & 7;
    const unsigned char* kg = (const unsigned char*)(P + ((size_t)b * SEQ + srow) * PW + CK0 + 64 * g) + sch * 16;
    const unsigned char* vg = (const unsigned char*)(P + ((size_t)b * SEQ + srow) * PW + CV0 + 64 * g) + sch * 16;
    const int kwo = srow * 128 + ((sch ^ ((srow >> 1) & 7)) * 16), vwo = 8192 + srow * 128 + sch * 16;
    const size_t tokg = (size_t)b * SEQ + tq;
    bf16x8 qf[4];
    { const bf16_t* qp = P + tokg * PW + CQ0 + 64 * hq + 8 * h;
#pragma unroll
      for (int s = 0; s < 4; ++s) qf[s] = *(const bf16x8*)(qp + 16 * s); }
    f32x16 o0, o1; float m = -1e30f, l = 0.f;
#pragma unroll
    for (int i = 0; i < 16; ++i) { o0[i] = 0.f; o1[i] = 0.f; }
    constexpr size_t TSTEP = (size_t)64 * PW * 2;
    u32x4 rk = *(const u32x4*)kg, rv = *(const u32x4*)vg;
    __syncthreads();
    *(LAS u32x4*)(lds + kwo) = rk; *(LAS u32x4*)(lds + vwo) = rv;
    rk = *(const u32x4*)(kg + TSTEP); rv = *(const u32x4*)(vg + TSTEP);
    __syncthreads();
#pragma unroll 1
    for (int kt = 0; kt < 32; ++kt) {
        LAS unsigned char* cur = lds + (kt & 1) * 16384;
        LAS unsigned char* nxt = lds + ((kt + 1) & 1) * 16384;
        if (kt + 1 < 32) { *(LAS u32x4*)(nxt + kwo) = rk; *(LAS u32x4*)(nxt + vwo) = rv; }
        if (kt + 2 < 32) { rk = *(const u32x4*)(kg + (size_t)(kt + 2) * TSTEP); rv = *(const u32x4*)(vg + (size_t)(kt + 2) * TSTEP); }
#pragma unroll
        for (int j = 0; j < 2; ++j) {
            bf16x8 kf[4], vf[2][2];
            load_kf(cur + j * 4096, kf, lane); load_vf(cur + 8192 + j * 4096, vf, lane);
            attn_step<false>(kf, cur, vf, qf, o0, o1, m, l, lane, 0);
        }
        __syncthreads();
    }
    const float lt = l + __shfl_xor(l, 32), inv = 1.0f / lt;
    bf16_t* op = MIX + tokg * DM + 640 + 64 * hq;
#pragma unroll
    for (int dt = 0; dt < 2; ++dt)
#pragma unroll
        for (int gg = 0; gg < 4; ++gg) {
            const f32x16& oo = dt ? o1 : o0;
            u32x2 w; w.x = pk2(oo[4 * gg] * inv, oo[4 * gg + 1] * inv); w.y = pk2(oo[4 * gg + 2] * inv, oo[4 * gg + 3] * inv);
            *(u32x2*)(op + 32 * dt + 8 * gg + 4 * h) = w;
        }
}

constexpr int HY_CP = 8192 + 16;
__device__ __forceinline__ void hy_filter(const Args& a, int L, int order, int c, LAS unsigned char* lds) {
    const int tid = tidx();
    LAS float* tmp = (LAS float*)(lds + 66048);
    LAS float* red = (LAS float*)(lds + 66048 + 16384);
    const float* raw = (const float*)(a.ws + WS_HRAW) + (size_t)L * 2048 * 1024 + order * 512 + c;
    float s = 0.f;
    for (int i = tid; i < 4096; i += 512) {
        float v;
        if (i < 2048) v = raw[(size_t)i * 1024];
        else if (i == 2048) v = 0.f;
        else v = raw[(size_t)(4096 - i) * 1024 + 256];
        tmp[i] = v; s += fabsf(v);
    }
    s = wave_sum(s);
    if ((tid & 63) == 0) red[tid >> 6] = s;
    __syncthreads();
    float tot = 0.f;
#pragma unroll
    for (int w = 0; w < 8; ++w) tot += red[w];
    const float inv = 1.0f / tot;
    for (int i = tid; i < 8 * 4096; i += 512) {
        const int q = i >> 12, x = i & 4095;
        const float v = tmp[(q - x) & 4095] * inv;
        *(LAS bf16_t*)(lds + q * HY_CP + x * 2) = (bf16_t)(pk2(v, 0.f) & 0xffffu);
    }
    __syncthreads();
}
template <int EPI>
__device__ __forceinline__ void hy_conv(const Args& a, int L, int c, const bf16_t* U, LAS unsigned char* lds) {
    const int tid = tidx(), wid = tid >> 6, lane = tid & 63, n = lane & 31, h = lane >> 5;
    const bf16_t* UC = (const bf16_t*)(a.ws + OFF_UC);
    bf16_t* Z = (bf16_t*)(a.ws + OFF_Z) + (size_t)c * MTOK;
    bf16_t* MIX = (bf16_t*)(a.ws + WS_MIX);
    const float dbias = a.in[18][L * 512 + EPI * 256 + c];
    const bf16_t* urow = U + (size_t)n * SEQ + 8 * h;
    LAS const unsigned char* fbase = lds + (n & 7) * HY_CP;
    const int foff = 8 * h - (n & ~7);
#pragma unroll 1
    for (int blk = 0; blk < 2; ++blk) {
        const int tb = 8 * wid + 4 * blk;
        f32x16 acc[4];
#pragma unroll
        for (int tt = 0; tt < 4; ++tt)
#pragma unroll
            for (int i = 0; i < 16; ++i) acc[tt][i] = 0.f;
        bf16x8 an[4];
#pragma unroll
        for (int k = 0; k < 4; ++k) an[k] = *(const bf16x8*)(urow + 16 * k);
#pragma unroll 1
        for (int s0 = 0; s0 < SEQ; s0 += 64) {
            bf16x8 ac[4];
#pragma unroll
            for (int k = 0; k < 4; ++k) ac[k] = an[k];
            if (s0 + 64 < SEQ) {
#pragma unroll
                for (int k = 0; k < 4; ++k) an[k] = *(const bf16x8*)(urow + s0 + 64 + 16 * k);
            }
            bf16x8 bfr[10];
            const int D0 = s0 - 32 * tb + foff;
#pragma unroll
            for (int d = 0; d < 10; ++d) { const int x = (D0 + 16 * (d - 6)) & 4095; bfr[d] = *(const LAS bf16x8*)(fbase + x * 2); }
            __builtin_amdgcn_sched_barrier(0);
#pragma unroll
            for (int k = 0; k < 4; ++k)
#pragma unroll
                for (int tt = 0; tt < 4; ++tt) acc[tt] = __builtin_amdgcn_mfma_f32_32x32x16_bf16(ac[k], bfr[k - 2 * tt + 6], acc[tt], 0, 0, 0);
            __builtin_amdgcn_sched_barrier(0);
        }
#pragma unroll
        for (int tt = 0; tt < 4; ++tt)
#pragma unroll
            for (int i = 0; i < 16; ++i) {
                const int bb = (i & 3) + 8 * (i >> 2) + 4 * h, t = 32 * (tb + tt) + n;
                const size_t tok = (size_t)bb * SEQ + t;
                if (EPI == 0) {
                    const float v = bf2f(UC[(size_t)c * MTOK + tok]), x1 = bf2f(UC[((size_t)256 + c) * MTOK + tok]);
                    const float z = x1 * (acc[tt][i] + dbias * v);
                    Z[tok] = (bf16_t)(pk2(z, 0.f) & 0xffffu);
                } else {
                    const float zz = bf2f(Z[tok]), x2 = bf2f(UC[((size_t)512 + c) * MTOK + tok]);
                    const float o = x2 * (acc[tt][i] + dbias * zz);
                    MIX[tok * DM + 384 + c] = (bf16_t)(pk2(o, 0.f) & 0xffffu);
                }
            }
    }
}
__device__ __forceinline__ void hyena_unit(const Args& a, int L, int c, LAS unsigned char* lds) {
    const int tid = tidx();
    const bf16_t* UT = (const bf16_t*)(a.ws + OFF_UT);
    bf16_t* UC = (bf16_t*)(a.ws + OFF_UC);
    const float* cwp = a.in[9] + L * 3 * 768; const float* cbp = a.in[10] + L * 768;
#pragma unroll 1
    for (int k3 = 0; k3 < 3; ++k3) {
        const int hc = 256 * k3 + c;
        const float w0 = cwp[hc], w1 = cwp[768 + hc], w2 = cwp[1536 + hc], bb = cbp[hc];
        const bf16_t* src = UT + (size_t)hc * MTOK; bf16_t* dst = UC + (size_t)hc * MTOK;
        for (int ck = tid; ck < MTOK / 8; ck += 512) {
            const int t0 = ck * 8, s = t0 & 2047;
            const u32x4 v = *(const u32x4*)(src + t0);
            float x[10];
            x[0] = (s == 0) ? 0.f : bf2f(src[t0 - 1]);
            x[1] = bflo(v.x); x[2] = bfhi(v.x); x[3] = bflo(v.y); x[4] = bfhi(v.y); x[5] = bflo(v.z); x[6] = bfhi(v.z); x[7] = bflo(v.w); x[8] = bfhi(v.w);
            x[9] = (s == 2040) ? 0.f : bf2f(src[t0 + 8]);
            float y[8];
#pragma unroll
            for (int j = 0; j < 8; ++j) y[j] = w0 * x[j] + w1 * x[j + 1] + w2 * x[j + 2] + bb;
            u32x4 o; o.x = pk2(y[0], y[1]); o.y = pk2(y[2], y[3]); o.z = pk2(y[4], y[5]); o.w = pk2(y[6], y[7]);
            *(u32x4*)(dst + t0) = o;
        }
    }
    __syncthreads();
    hy_filter(a, L, 0, c, lds);
    hy_conv<0>(a, L, c, UC + (size_t)c * MTOK, lds);
    __syncthreads();
    hy_filter(a, L, 1, c, lds);
    hy_conv<1>(a, L, c, (const bf16_t*)(a.ws + OFF_Z) + (size_t)c * MTOK, lds);
    __syncthreads();
}

__device__ __forceinline__ void row_pass(const bf16_t* F, const float* xold, float* xnew, const float* gpost, const float* gnext, bf16_t* H, int G, int c) {
    const int tid = tidx(), wid = tid >> 6; int lane = tid & 63; asm volatile("" : "+v"(lane));
    f32x4 gp[4], gn[4];
#pragma unroll
    for (int j = 0; j < 4; ++j) { gp[j] = *(const f32x4*)(gpost + 4 * lane + 256 * j); gn[j] = gnext ? *(const f32x4*)(gnext + 4 * lane + 256 * j) : (f32x4){0.f, 0.f, 0.f, 0.f}; }
    for (int rb = (c * 8 + wid) * 32; rb < MTOK; rb += G * 8 * 32) {
#pragma unroll 1
        for (int k = 0; k < 32; k += 4) {
            u32x2 fw[4][4]; f32x4 x[4][4];
#pragma unroll
            for (int u = 0; u < 4; ++u) {
                const size_t ro = (size_t)(rb + k + u) * DM + 4 * lane;
#pragma unroll
                for (int j = 0; j < 4; ++j) { fw[u][j] = *(const u32x2*)(F + ro + 256 * j); x[u][j] = *(const f32x4*)(xold + ro + 256 * j); }
            }
#pragma unroll
            for (int u = 0; u < 4; ++u) {
                const size_t ro = (size_t)(rb + k + u) * DM + 4 * lane;
                f32x4 f[4]; float s = 0.f;
#pragma unroll
                for (int j = 0; j < 4; ++j) { f[j] = (f32x4){bflo(fw[u][j].x), bfhi(fw[u][j].x), bflo(fw[u][j].y), bfhi(fw[u][j].y)}; s += (f[j][0] * f[j][0] + f[j][1] * f[j][1]) + (f[j][2] * f[j][2] + f[j][3] * f[j][3]); }
                const float rstd = rsqrtf(wave_sum(s) * (1.0f / DM) + EPS);
                float s2 = 0.f;
#pragma unroll
                for (int j = 0; j < 4; ++j) { x[u][j] = x[u][j] + f[j] * rstd * gp[j]; *(f32x4*)(xnew + ro + 256 * j) = x[u][j]; s2 += (x[u][j][0] * x[u][j][0] + x[u][j][1] * x[u][j][1]) + (x[u][j][2] * x[u][j][2] + x[u][j][3] * x[u][j][3]); }
                if (gnext) {
                    const float rstd2 = rsqrtf(wave_sum(s2) * (1.0f / DM) + EPS);
#pragma unroll
                    for (int j = 0; j < 4; ++j) { const f32x4 y = x[u][j] * rstd2 * gn[j]; u32x2 w; w.x = pk2(y[0], y[1]); w.y = pk2(y[2], y[3]); *(u32x2*)(H + ro + 256 * j) = w; }
                }
            }
        }
    }
}

__device__ __forceinline__ void ffn_fixup(const Args& a, int L, int panel) {
    const float* EP = (const float*)(a.ws + OFF_EP); const float* EG = (const float*)(a.ws + OFF_EG); const float* EU = (const float*)(a.ws + OFF_EU);
    bf16_t* ACT = (bf16_t*)(a.ws + WS_P);
    const float* cw = a.in[21] + (size_t)L * 3 * FF;
    int tid0 = tidx(); asm volatile("" : "+v"(tid0));
    for (int i = tid0; i < 8 * FF; i += 512) {
        const int e = i / FF, c = i % FF, gi = 4 * panel + (e >> 1), side = e & 1;
        const int row = 64 * gi + (side ? 63 : 0);
        const size_t eo = ((size_t)gi * 2 + side) * FF + c;
        float nb = 0.f, w;
        if (side == 0) { w = cw[c]; if ((row & 2047) != 0) nb = EG[((size_t)(gi - 1) * 2 + 1) * FF + c]; }
        else { w = cw[2 * FF + c]; if ((row & 2047) != 2047) nb = EG[((size_t)(gi + 1) * 2) * FF + c]; }
        const float pre = EP[eo] + w * nb;
        const float act = gelu_tanh(pre) * EU[eo];
        ACT[(size_t)row * FF + c] = (bf16_t)(pk2(act, 0.f) & 0xffffu);
    }
}

__device__ __forceinline__ void run_phase(const Args& a0, int ph, LAS unsigned char* lds) {
    Args a = a0;
#pragma unroll
    for (int i = 0; i < 24; ++i) { const __attribute__((address_space(1))) float* p = (const __attribute__((address_space(1))) float*)a0.in[i]; asm volatile("" : "+s"(p)); a.in[i] = (const float*)p; }
    { __attribute__((address_space(1))) float* p = (__attribute__((address_space(1))) float*)a0.out; asm volatile("" : "+s"(p)); a.out = (float*)p; }
    { __attribute__((address_space(1))) unsigned char* p = (__attribute__((address_space(1))) unsigned char*)a0.ws; asm volatile("" : "+s"(p)); a.ws = (unsigned char*)p; }
    int G = gridDim.x, c = blockIdx.x; asm volatile("" : "+s"(G), "+s"(c));
#ifndef PHM
#define PHM 63
#endif
    if (ph == 0) { for (int rep = 0; rep < NREP(32); ++rep) { phase0(a, lds); __syncthreads(); } return; }
    const int L = (ph - 1) / 7, sub = (ph - 1) % 7;
    bf16_t* H = (bf16_t*)(a.ws + WS_H);
    bf16_t* Fb = (bf16_t*)(a.ws + WS_F);
    if (sub == 0) {
        pg8::Gemm g{H, (const bf16_t*)(a.ws + WS_WIN) + (size_t)L * PW * DM, MTOK, PW, DM};
        pg8::StaticOrder S; S.init(MTOK, PW, G, c);
        EpiIn E{(bf16_t*)(a.ws + WS_P), (bf16_t*)(a.ws + OFF_UT), (const float*)(a.ws + WS_RAC), (const float*)(a.ws + WS_RAS), (const float*)(a.ws + WS_RCC), (const float*)(a.ws + WS_RCS),
                a.in[7] + L * 64, a.in[8] + L * 64, lds + 131072};
        for (int rep = 0; rep < NREP(8); ++rep) pg8::gemm_phase(lds, g, S, E);
    } else if (sub == 1) {
        for (int rep = 0; rep < NREP(1); ++rep) for (int ch = c; ch < 256; ch += G) hyena_unit(a, L, ch, lds);
        for (int rep = 0; rep < NREP(2); ++rep) for (int u = c; u < 1536; u += G) attnC_unit(a, u, lds);
        for (int rep = 0; rep < NREP(4); ++rep) { __syncthreads(); for (int u = c; u < 768; u += G) { attnA_unit(a, u, lds); __syncthreads(); } }
    } else if (sub == 2) {
        pg8::Gemm g{(const bf16_t*)(a.ws + WS_MIX), (const bf16_t*)(a.ws + WS_WOUT) + (size_t)L * DM * DM, MTOK, DM, DM};
        pg8::StaticOrder S; S.init(MTOK, DM, G, c); EpiF E{Fb};
        for (int rep = 0; rep < NREP(64); ++rep) pg8::gemm_phase(lds, g, S, E);
    } else if (sub == 3) {
        row_pass(Fb, L == 0 ? a.in[0] : a.out, a.out, a.in[2] + L * DM, a.in[3] + L * DM, H, G, c);
    } else if (sub == 4) {
        pg8::Gemm g{H, (const bf16_t*)(a.ws + WS_WGU) + (size_t)L * 2 * FF * DM, MTOK, 2 * FF, DM};
        pg8::StaticOrder S; S.init(MTOK, 2 * FF, G, c);
        EpiGU E{(bf16_t*)(a.ws + WS_P), (float*)(a.ws + OFF_EP), (float*)(a.ws + OFF_EG), (float*)(a.ws + OFF_EU), a.in[21] + (size_t)L * 3 * FF, a.in[22] + (size_t)L * FF};
        for (int rep = 0; rep < NREP(16); ++rep) pg8::gemm_phase(lds, g, S, E);
    } else if (sub == 5) {
        pg8::Gemm g{(const bf16_t*)(a.ws + WS_P), (const bf16_t*)(a.ws + WS_WDN) + (size_t)L * DM * FF, MTOK, DM, FF};
        pg8::StaticOrder S; S.init(MTOK, DM, G, c); EpiF E{Fb};
        { Unit u; int last = -1; for (int i = 0; S.next(i, u); ++i) if (u.pm != last) { ffn_fixup(a, L, u.pm); last = u.pm; } }
        __syncthreads();
        pg8::gemm_phase(lds, g, S, E);
    } else {
        row_pass(Fb, a.out, a.out, a.in[4] + L * DM, L == 0 ? a.in[1] + DM : nullptr, H, G, c);
    }
}

#define XB_TMO      128
#define XB_XCNT(j)  (256  + 64 * (j))
#define XB_XSUB(j)  (1280 + 64 * (j))
#define XB_XGEN(j)  (2304 + 64 * (j))
#define XB_TOP      3328
#define XB_TOPGEN   3392
#define XB_SPIN_CAP (1u << 22)
__device__ __forceinline__ unsigned xb_ld(unsigned* p)              { return __hip_atomic_load(p, __ATOMIC_RELAXED, __HIP_MEMORY_SCOPE_AGENT); }
__device__ __forceinline__ unsigned xb_add(unsigned* p, unsigned v) { return __hip_atomic_fetch_add(p, v, __ATOMIC_RELAXED, __HIP_MEMORY_SCOPE_AGENT); }
__device__ __forceinline__ unsigned xb_xcc_id() { return (unsigned)__builtin_amdgcn_s_getreg((3 << 11) | 20) & 0xFu; }
#define XB_SPIN(cond, bar) do { unsigned _sp = 0; while (cond) { __builtin_amdgcn_s_sleep(1); \
    if ((++_sp & 255u) == 0u) { if (xb_ld(&(bar)[XB_TMO])) break; if (_sp > XB_SPIN_CAP) { atomicAdd(&(bar)[XB_TMO], 1u); break; } } } } while (0)
struct XbCensus { unsigned nloc, nx; };
__device__ __forceinline__ XbCensus xcd_barrier_complete(unsigned* bar, unsigned x) {
    const unsigned G = gridDim.x;
    unsigned sum, cnt, mine, sp = 0u;
    for (;;) {
        sum = 0u; cnt = 0u; mine = 0u;
#pragma unroll
        for (unsigned j = 0; j < 16; ++j) { const unsigned c = xb_ld(&bar[XB_XCNT(j)]); sum += c; cnt += (c > 0u) ? 1u : 0u; mine = (j == x) ? c : mine; }
        if (sum == G) break;
        __builtin_amdgcn_s_sleep(1);
        if ((++sp & 255u) == 0u) { if (xb_ld(&bar[XB_TMO])) break; if (sp > XB_SPIN_CAP) { atomicAdd(&bar[XB_TMO], 1u); break; } }
    }
    XbCensus r; r.nloc = mine > 0u ? mine : 1u; r.nx = cnt > 0u ? cnt : 1u; return r;
}
__device__ __forceinline__ void xcd_barrier(unsigned* bar, unsigned x, bool first) {
    asm volatile("s_waitcnt vmcnt(0)" ::: "memory");
    __syncthreads();
    if (threadIdx.x == 0) {
        __builtin_amdgcn_s_waitcnt(0);
        unsigned* slot = bar + 4096 + 2 * blockIdx.x;
        XbCensus cs;
        if (first) { cs = xcd_barrier_complete(bar, x); slot[0] = cs.nloc; slot[1] = cs.nx; }
        else { cs.nloc = xb_ld(slot); cs.nx = xb_ld(slot + 1); }
        const unsigned nloc = cs.nloc, nx = cs.nx;
        const unsigned old = xb_add(&bar[XB_XSUB(x)], 1u);
        const unsigned gen = old / nloc;
        if (old + 1u == (gen + 1u) * nloc) {
            __builtin_amdgcn_fence(__ATOMIC_RELEASE, "agent");
            asm volatile("s_waitcnt vmcnt(0)" ::: "memory");
            const unsigned og = xb_add(&bar[XB_TOP], 1u);
            const unsigned tg = og / nx;
            if (og + 1u == (tg + 1u) * nx) xb_add(&bar[XB_TOPGEN], 1u);
            else XB_SPIN(xb_ld(&bar[XB_TOPGEN]) == tg, bar);
            __builtin_amdgcn_fence(__ATOMIC_ACQUIRE, "agent");
            xb_add(&bar[XB_XGEN(x)], 1u);
            asm volatile("s_waitcnt vmcnt(0)" ::: "memory");
        } else {
            XB_SPIN(xb_ld(&bar[XB_XGEN(x)]) == gen, bar);
            __builtin_amdgcn_fence(__ATOMIC_ACQUIRE, "agent");
            asm volatile("s_waitcnt vmcnt(0)" ::: "memory");
        }
    }
    __syncthreads();
}

__global__ __launch_bounds__(512, 2) void mk_fwd(Args a) {
    extern __shared__ __attribute__((aligned(16))) unsigned char lds_raw[];
    LAS unsigned char* lds = (LAS unsigned char*)lds_raw;
    unsigned* bar = (unsigned*)a.ws;
    unsigned xcc = 0u;
    if (a.coop) { xcc = xb_xcc_id(); if (threadIdx.x == 0) (void)xb_add(&bar[XB_XCNT(xcc)], 1u); }
    (void)xcc;
    for (int ph = a.ph_lo; ph < a.ph_hi; ++ph) {
        run_phase(a, ph, lds);
        if (a.coop && ph + 1 < a.ph_hi) {
            if (ph == 0) cg::this_grid().sync();
            else xcd_barrier(bar, xb_xcc_id(), ph == 1);
        }
    }
}

extern "C" void kernel_launch(void* const* d_in, const int* in_sizes, int n_in, void* d_out, int out_size, void* d_ws, size_t ws_size, hipStream_t stream) {
    static int grid = 0;
    if (grid == 0) {
        if (n_in != 24 || out_size != MTOK * DM || ws_size < WS_END) { fprintf(stderr, "kernel_launch: unexpected shapes / workspace (n_in %d out %d ws %zu need %zu)\n", n_in, out_size, ws_size, (size_t)WS_END); grid = -1; return; }
        int dev = 0, cus = 0, per_cu = 0;
        hipGetDevice(&dev); hipDeviceGetAttribute(&cus, hipDeviceAttributeMultiprocessorCount, dev);
        if (hipFuncSetAttribute((const void*)mk_fwd, hipFuncAttributeMaxDynamicSharedMemorySize, LDS_BYTES) != hipSuccess) { fprintf(stderr, "kernel_launch: hipFuncSetAttribute failed\n"); grid = -1; return; }
        if (hipOccupancyMaxActiveBlocksPerMultiprocessor(&per_cu, (const void*)mk_fwd, 512, LDS_BYTES) != hipSuccess || per_cu < 1) { fprintf(stderr, "kernel_launch: occupancy query says %d\n", per_cu); per_cu = 1; }
        (void)hipGetLastError();
        grid = cus;
    }
    if (grid < 0) return;
    if (hipMemsetAsync(d_ws, 0, 32768, stream) != hipSuccess) { fprintf(stderr, "kernel_launch: memset of the barrier words failed\n"); return; }
    Args a{};
    for (int i = 0; i < 24; ++i) a.in[i] = (const float*)d_in[i];
    a.out = (float*)d_out; a.ws = (unsigned char*)d_ws;
#if MK_COOP
    a.ph_lo = 0; a.ph_hi = NPH; a.coop = 1;
    void* args[] = {&a};
    hipError_t e = hipLaunchCooperativeKernel((const void*)mk_fwd, dim3(grid), dim3(512), args, LDS_BYTES, stream);
    if (e != hipSuccess) fprintf(stderr, "cooperative launch failed: %s (grid %d)\n", hipGetErrorString(e), grid);
#else
    for (int ph = 0; ph < NPH; ++ph) {
        a.ph_lo = ph; a.ph_hi = ph + 1; a.coop = 0;
        hipLaunchKernelGGL(mk_fwd, dim3(grid), dim3(512), LDS_BYTES, stream, a);
    }
#endif
}
```

```cpp
#include <hip/hip_runtime.h>
#include <hip/hip_cooperative_groups.h>
#include <cstdio>
namespace cg = cooperative_groups;

#ifndef NPH
#define NPH 15
#endif
#ifndef REPM
#define REPM 0
#endif
#define NREP(bit) ((REPM & (bit)) ? 2 : 1)
#ifndef MK_COOP
#define MK_COOP 1
#endif

#define LAS __attribute__((address_space(3)))
typedef unsigned short bf16_t;
typedef short bf16x8 __attribute__((ext_vector_type(8)));
typedef short bf16x4 __attribute__((ext_vector_type(4)));
typedef float f32x4 __attribute__((ext_vector_type(4)));
typedef float f32x16 __attribute__((ext_vector_type(16)));
typedef unsigned u32x4 __attribute__((ext_vector_type(4)));
typedef unsigned u32x2 __attribute__((ext_vector_type(2)));

constexpr int NB = 32, SEQ = 2048, DM = 1024, MTOK = NB * SEQ, PW = 2560, FF = 2816;
constexpr int CQ0 = 1920, CK0 = 2304, CV0 = 2432;
constexpr float LOG2E = 1.4426950408889634f;
constexpr float EPS = 1e-6f;

constexpr size_t WS_RAC = 32768;
constexpr size_t WS_RAS = WS_RAC + 2048 * 32 * 4;
constexpr size_t WS_RCC = WS_RAS + 2048 * 32 * 4;
constexpr size_t WS_RCS = WS_RCC + 64 * 16 * 4;
constexpr size_t WS_WIN = WS_RCS + 64 * 16 * 4;
constexpr size_t WS_WOUT = WS_WIN + 2ull * 2560 * 1024 * 2;
constexpr size_t WS_WGU = WS_WOUT + 2ull * 1024 * 1024 * 2;
constexpr size_t WS_WDN = WS_WGU + 2ull * 5632 * 1024 * 2;
constexpr size_t WS_HRAW = WS_WDN + 2ull * 1024 * 2816 * 2;
constexpr size_t WS_H = WS_HRAW + 2ull * 2048 * 1024 * 4;
constexpr size_t WS_P = WS_H + (size_t)MTOK * 1024 * 2;
constexpr size_t WS_MIX = WS_P + (size_t)MTOK * 2816 * 2;
constexpr size_t WS_F = WS_MIX + (size_t)MTOK * 1024 * 2;
constexpr size_t WS_END = WS_F + (size_t)MTOK * 1024 * 4;
constexpr size_t OFF_UC = WS_H, OFF_Z = WS_H + 3ull * 256 * MTOK * 2;
constexpr size_t OFF_UT = WS_F, OFF_OA = WS_F + 768ull * MTOK * 2, OFF_LSE = OFF_OA + 2ull * MTOK * 384 * 2;
constexpr size_t EDGE_SZ = 1024ull * 2 * FF * 4;
constexpr size_t OFF_EP = WS_MIX, OFF_EG = WS_MIX + EDGE_SZ, OFF_EU = WS_MIX + 2 * EDGE_SZ;
constexpr int LDS_BYTES = 163840;

struct Args { const float* in[24]; float* out; unsigned char* ws; int ph_lo, ph_hi, coop, pad; };

__device__ __forceinline__ int tidx() { int t = threadIdx.x; asm volatile("" : "+v"(t)); return t; }
__device__ __forceinline__ unsigned pk2(float lo, float hi) { unsigned r; asm("v_cvt_pk_bf16_f32 %0, %1, %2" : "=v"(r) : "v"(lo), "v"(hi)); return r; }
typedef float f32x2v __attribute__((ext_vector_type(2)));
typedef __bf16 bf16v2 __attribute__((ext_vector_type(2)));
__device__ __forceinline__ unsigned pk2n(float lo, float hi) { const f32x2v v = {lo, hi}; const bf16v2 b = __builtin_convertvector(v, bf16v2); return __builtin_bit_cast(unsigned, b); }
__device__ __forceinline__ float bf2f(bf16_t b) { return __uint_as_float(((unsigned)b) << 16); }
__device__ __forceinline__ float bflo(unsigned w) { return __uint_as_float(w << 16); }
__device__ __forceinline__ float bfhi(unsigned w) { return __uint_as_float(w & 0xffff0000u); }
__device__ __forceinline__ float wave_sum(float v) {
#pragma unroll
    for (int o = 1; o < 64; o <<= 1) v += __shfl_xor(v, o);
    return v;
}
__device__ __forceinline__ float fexp2(float x) { return __builtin_amdgcn_exp2f(x); }
__device__ __forceinline__ float gelu_tanh(float x) {
    const float u = x * (1.0f + 0.044715f * x * x);
    const float e = fexp2(-2.0f * 0.7978845608028654f * LOG2E * u);
    return x * __builtin_amdgcn_rcpf(1.0f + e);
}

namespace pg8 {
constexpr int BM = 256, BK = 64, HALF = 128, HTB = HALF * BK * 2, STAGE_BYTES = 8 * HTB, NXCD = 8, WGM = 8;
__device__ __forceinline__ int lds_byte(int r, int c) { const int st = (r >> 4) * 2 + (c >> 5), rr = r & 15, cc = c & 31, ob = rr * 64 + cc * 2; return st * 1024 + (ob ^ (((ob >> 9) & 1) << 5)); }
__device__ __forceinline__ void stage_rc(int b, int& R, int& C) { const int st = b / 1024, sb = b % 1024, swz = sb ^ (((sb >> 9) & 1) << 5); R = (st >> 1) * 16 + swz / 64; C = (st & 1) * 32 + (swz % 64) / 2; }
struct Unit { int pm, pn; };
struct Gemm { const bf16_t* A; const bf16_t* Bt; int M, N, K; };
struct StaticOrder {
    int nM, nN, nwg, G, c;
    __device__ void init(int M, int N, int G_, int c_) { nM = M / BM; nN = N / BM; nwg = nM * nN; G = G_; c = c_; }
    __device__ __forceinline__ bool next(int i, Unit& u) const {
        const long L = (long)i * G + c; if (L >= nwg) return false;
        int wgid = (int)L; { const int q = nwg / NXCD, r = nwg % NXCD, xcd = wgid % NXCD, off = wgid / NXCD; wgid = (xcd < r ? xcd * (q + 1) : r * (q + 1) + (xcd - r) * q) + off; }
        const int nig = WGM * nN, gid = wgid / nig, fm = gid * WGM, gsz = (nM - fm) < WGM ? (nM - fm) : WGM;
        u.pm = fm + ((wgid % nig) % gsz); u.pn = (wgid % nig) / gsz; return true;
    }
};
struct PanelOrder {
    int pm;
    __device__ __forceinline__ bool next(int i, Unit& u) const { if (i >= 4) return false; u.pm = pm; u.pn = i; return true; }
};

template <class Epi, class Sched>
__device__ __forceinline__ void gemm_phase(LAS unsigned char* lds, const Gemm g, const Sched& S, const Epi& E) {
    const int tid = tidx(), wid = __builtin_amdgcn_readfirstlane(tid >> 6), lane = tid & 63, wr = wid >> 2, wc = wid & 3, fr = lane & 15, fq = lane >> 4;
    const int K = g.K, nt = K / BK;
    unsigned voffA[2], voffB[2];
#pragma unroll
    for (int i = 0; i < 2; ++i) { int R, C; stage_rc(tid * 16 + i * 8192, R, C); voffA[i] = (unsigned)(R * K + C) * 2u; voffB[i] = voffA[i]; }
    const size_t kstep = (size_t)(BK * 2);
    const size_t hstep = (size_t)HALF * K * 2;
    const size_t tstep = 2 * hstep;
    const unsigned ldsw = (unsigned)wid * 1024u;
    const int aoff = lds_byte(wr * 64 + fr, fq * 8), boff = lds_byte(wc * 32 + fr, fq * 8);
#define PG8_SA(b, h) (((b) * 2 + (h)) * HTB)
#define PG8_SB(b, h) ((4 + (b) * 2 + (h)) * HTB)
#define PG8_STAGE(bufoff, gbase, voff) do { _Pragma("unroll") for (int _i = 0; _i < 2; ++_i) \
        __builtin_amdgcn_global_load_lds((const unsigned*)((const char*)(gbase) + (voff)[_i]), (LAS unsigned*)(lds + (bufoff) + ldsw + _i * 8192), 16, 0, 0); } while (0)
#define PG8_LDA(dst, b, h) do { _Pragma("unroll") for (int m = 0; m < 4; ++m) _Pragma("unroll") for (int k = 0; k < 2; ++k) dst[m][k] = *(const LAS bf16x8*)(lds + PG8_SA(b, h) + aoff + m * 2048 + k * 1024); } while (0)
#define PG8_LDB(dst, b, h) do { _Pragma("unroll") for (int n = 0; n < 2; ++n) _Pragma("unroll") for (int k = 0; k < 2; ++k) dst[n][k] = *(const LAS bf16x8*)(lds + PG8_SB(b, h) + boff + n * 2048 + k * 1024); } while (0)
#define PG8_MMA(ai, bj, At, Bt) do { __builtin_amdgcn_s_setprio(1); _Pragma("unroll") for (int m = 0; m < 4; ++m) _Pragma("unroll") for (int n = 0; n < 2; ++n) _Pragma("unroll") for (int k = 0; k < 2; ++k) \
        acc[ai][bj][m][n] = __builtin_amdgcn_mfma_f32_16x16x32_bf16(Bt[n][k], At[m][k], acc[ai][bj][m][n], 0, 0, 0); __builtin_amdgcn_s_setprio(0); } while (0)
#define PG8_WAIT_V(n) asm volatile("s_waitcnt vmcnt(" #n ")" ::: "memory")
#define PG8_WAIT_L(n) asm volatile("s_waitcnt lgkmcnt(" #n ")" ::: "memory")
#define PG8_BAR __builtin_amdgcn_s_barrier()
#define PG8_SCHED __builtin_amdgcn_sched_barrier(0)
    Unit cur, nxt; int ui = 0;
    if (!S.next(0, cur)) return;
    f32x4 acc[2][2][4][2];
#pragma unroll
    for (int a = 0; a < 2; ++a)
#pragma unroll
        for (int b = 0; b < 2; ++b)
#pragma unroll
            for (int m = 0; m < 4; ++m)
#pragma unroll
                for (int n = 0; n < 2; ++n) acc[a][b][m][n] = (f32x4){0.f, 0.f, 0.f, 0.f};
    bf16x8 At[4][2], B0[2][2], B1[2][2];
    const char* cA = (const char*)g.A + (size_t)cur.pm * tstep; const char* cB = (const char*)g.Bt + (size_t)cur.pn * tstep;
    PG8_STAGE(PG8_SB(0, 0), cB, voffB); PG8_STAGE(PG8_SA(0, 0), cA, voffA); PG8_STAGE(PG8_SB(0, 1), cB + hstep, voffB); PG8_STAGE(PG8_SA(0, 1), cA + hstep, voffA);
    if (wr == 1) PG8_BAR;
    PG8_WAIT_V(4); PG8_BAR;
    PG8_STAGE(PG8_SB(1, 0), cB + kstep, voffB); PG8_STAGE(PG8_SA(1, 0), cA + kstep, voffA); PG8_STAGE(PG8_SB(1, 1), cB + hstep + kstep, voffB);
    PG8_WAIT_V(6); PG8_BAR;
    for (;;) {
        const bool has_next = S.next(ui + 1, nxt);
        const char* nA = has_next ? (const char*)g.A + (size_t)nxt.pm * tstep : cA; const char* nB = has_next ? (const char*)g.Bt + (size_t)nxt.pn * tstep : cB;
        for (int t = 0; t < nt; t += 2) {
            const bool last = (t == nt - 2);
            const char* a1 = cA + (size_t)(t + 1) * kstep;
            const char* a2 = last ? nA : cA + (size_t)(t + 2) * kstep; const char* b2 = last ? nB : cB + (size_t)(t + 2) * kstep;
            const char* a3 = a2 + kstep; const char* b3 = b2 + kstep;
            PG8_LDB(B0, 0, 0); PG8_SCHED; PG8_LDA(At, 0, 0); PG8_STAGE(PG8_SA(1, 1), a1 + hstep, voffA);
            PG8_WAIT_L(8); PG8_BAR; PG8_WAIT_L(0); PG8_MMA(0, 0, At, B0); PG8_BAR; PG8_SCHED;
            PG8_LDB(B1, 0, 1); PG8_STAGE(PG8_SB(0, 0), b2, voffB);
            PG8_BAR; PG8_WAIT_L(0); PG8_MMA(0, 1, At, B1); PG8_BAR;
            PG8_LDA(At, 0, 1); PG8_STAGE(PG8_SA(0, 0), a2, voffA);
            PG8_BAR; PG8_WAIT_L(0); PG8_MMA(1, 0, At, B0); PG8_BAR; PG8_SCHED;
            PG8_STAGE(PG8_SB(0, 1), b2 + hstep, voffB);
            PG8_WAIT_V(6); PG8_BAR; PG8_MMA(1, 1, At, B1); PG8_BAR;
            PG8_LDB(B0, 1, 0); PG8_SCHED; PG8_LDA(At, 1, 0); PG8_STAGE(PG8_SA(0, 1), a2 + hstep, voffA);
            PG8_WAIT_L(8); PG8_BAR; PG8_WAIT_L(0); PG8_MMA(0, 0, At, B0); PG8_BAR; PG8_SCHED;
            PG8_LDB(B1, 1, 1); PG8_STAGE(PG8_SB(1, 0), b3, voffB);
            PG8_BAR; PG8_WAIT_L(0); PG8_MMA(0, 1, At, B1); PG8_BAR;
            PG8_LDA(At, 1, 1); PG8_STAGE(PG8_SA(1, 0), a3, voffA);
            PG8_BAR; PG8_WAIT_L(0); PG8_MMA(1, 0, At, B0); PG8_BAR; PG8_SCHED;
            PG8_STAGE(PG8_SB(1, 1), b3 + hstep, voffB);
            PG8_WAIT_V(6); PG8_BAR; PG8_MMA(1, 1, At, B1); PG8_BAR;
        }
        E(acc, cur, wr, wc, fr, fq);
        if (!has_next) break;
#pragma unroll
        for (int a = 0; a < 2; ++a)
#pragma unroll
            for (int b = 0; b < 2; ++b)
#pragma unroll
                for (int m = 0; m < 4; ++m)
#pragma unroll
                    for (int n = 0; n < 2; ++n) acc[a][b][m][n] = (f32x4){0.f, 0.f, 0.f, 0.f};
        cur = nxt; cA = nA; cB = nB; ++ui;
    }
    PG8_WAIT_V(0);
    if (wr == 0) PG8_BAR;
    PG8_BAR;
#undef PG8_SA
#undef PG8_SB
#undef PG8_STAGE
#undef PG8_LDA
#undef PG8_LDB
#undef PG8_MMA
#undef PG8_WAIT_V
#undef PG8_WAIT_L
#undef PG8_BAR
#undef PG8_SCHED
}
}
using pg8::Unit;

struct EpiIn {
    bf16_t* P; bf16_t* UT; const float* rac; const float* ras; const float* rcc; const float* rcs; const float* gq; const float* gk; LAS unsigned char* scr;
    __device__ __forceinline__ void operator()(const f32x4 (&acc)[2][2][4][2], const Unit& uu, int wr, int wc, int fr, int fq) const {
        Unit u = uu; asm volatile("" : "+s"(u.pm), "+s"(u.pn), "+v"(fr), "+v"(fq));
        const int ch = 4 * u.pn + wc;
        const int rowb = u.pm * 256 + wr * 64 + fr;
        if (ch < 12) {
            const float qs = (ch < 6) ? 0.125f * LOG2E : 1.0f;
#pragma unroll
            for (int ai = 0; ai < 2; ++ai)
#pragma unroll
                for (int m = 0; m < 4; ++m) {
                    const int r = rowb + 128 * ai + 16 * m, s = r & 2047;
                    u32x4 w1, w2;
                    {
                        const f32x4 c0 = *(const f32x4*)(rac + s * 32 + 8 * fq), s0 = *(const f32x4*)(ras + s * 32 + 8 * fq);
                        const f32x4 c1 = *(const f32x4*)(rac + s * 32 + 8 * fq + 4), s1 = *(const f32x4*)(ras + s * 32 + 8 * fq + 4);
                        const f32x4 x10 = acc[ai][0][m][0], x11 = acc[ai][0][m][1], x20 = acc[ai][1][m][0], x21 = acc[ai][1][m][1];
                        const f32x4 a0 = (x10 * c0 - x20 * s0) * qs, a1 = (x11 * c1 - x21 * s1) * qs;
                        const f32x4 b0 = (x20 * c0 + x10 * s0) * qs, b1 = (x21 * c1 + x11 * s1) * qs;
                        w1.x = pk2(a0[0], a0[1]); w1.y = pk2(a0[2], a0[3]); w1.z = pk2(a1[0], a1[1]); w1.w = pk2(a1[2], a1[3]);
                        w2.x = pk2(b0[0], b0[1]); w2.y = pk2(b0[2], b0[3]); w2.z = pk2(b1[0], b1[1]); w2.w = pk2(b1[2], b1[3]);
                    }
                    bf16_t* dst = P + (size_t)r * PW + 64 * ch + 8 * fq;
                    *(u32x4*)dst = w1; *(u32x4*)(dst + 32) = w2;
                }
        } else if (ch < 18 || ch >= 38) {
#pragma unroll
            for (int ai = 0; ai < 2; ++ai)
#pragma unroll
                for (int m = 0; m < 4; ++m) {
                    const int r = rowb + 128 * ai + 16 * m;
                    bf16_t* dst = P + (size_t)r * PW + 64 * ch + 8 * fq;
#pragma unroll
                    for (int bj = 0; bj < 2; ++bj) {
                        const f32x4 v0 = acc[ai][bj][m][0], v1 = acc[ai][bj][m][1];
                        u32x4 w; w.x = pk2(v0[0], v0[1]); w.y = pk2(v0[2], v0[3]); w.z = pk2(v1[0], v1[1]); w.w = pk2(v1[2], v1[3]);
                        *(u32x4*)(dst + 32 * bj) = w;
                    }
                }
        } else if (ch < 30) {
            const int wid = wr * 4 + wc, lane = fq * 16 + fr;
            LAS unsigned char* T = scr + wid * 4096;
#pragma unroll
            for (int ai = 0; ai < 2; ++ai)
#pragma unroll
                for (int bj = 0; bj < 2; ++bj) {
#pragma unroll
                    for (int m = 0; m < 4; ++m)
#pragma unroll
                        for (int n = 0; n < 2; ++n)
#pragma unroll
                            for (int j = 0; j < 4; ++j) {
                                const int chl = 8 * fq + 4 * n + j, rl = 16 * m + fr;
                                *(LAS bf16_t*)(T + chl * 128 + rl * 2) = (bf16_t)(pk2(acc[ai][bj][m][n][j], 0.f) & 0xffffu);
                            }
                    asm volatile("s_waitcnt lgkmcnt(0)" ::: "memory");
                    const int r0 = u.pm * 256 + 128 * ai + 64 * wr;
                    const int hc0 = 64 * (ch - 18) + 32 * bj;
#pragma unroll
                    for (int q = 0; q < 4; ++q) {
                        const int idx = q * 64 + lane, chl = idx >> 3, k = idx & 7;
                        const u32x4 v = *(const LAS u32x4*)(T + chl * 128 + k * 16);
                        *(u32x4*)(UT + (size_t)(hc0 + chl) * MTOK + r0 + 8 * k) = v;
                    }
                    asm volatile("s_waitcnt lgkmcnt(0)" ::: "memory");
                }
        } else {
            const float* g = (ch < 36) ? gq : gk;
            const float qs = (ch < 36) ? 0.125f * LOG2E : 1.0f;
            f32x4 g4[2][2];
#pragma unroll
            for (int bj = 0; bj < 2; ++bj)
#pragma unroll
                for (int n = 0; n < 2; ++n) g4[bj][n] = *(const f32x4*)(g + 32 * bj + 16 * n + 4 * fq);
#pragma unroll
            for (int ai = 0; ai < 2; ++ai)
#pragma unroll
                for (int m = 0; m < 4; ++m) {
                    const int r = rowb + 128 * ai + 16 * m, s = r & 2047;
                    float ss = 0.f;
#pragma unroll
                    for (int bj = 0; bj < 2; ++bj)
#pragma unroll
                        for (int n = 0; n < 2; ++n) { const f32x4 x = acc[ai][bj][m][n]; ss += (x[0] * x[0] + x[1] * x[1]) + (x[2] * x[2] + x[3] * x[3]); }
                    ss += __shfl_xor(ss, 16); ss += __shfl_xor(ss, 32);
                    const float rstd = rsqrtf(ss * (1.0f / 64.0f) + EPS) * qs;
                    bf16_t* dst = P + (size_t)r * PW + 64 * ch + 8 * fq;
#pragma unroll
                    for (int bj = 0; bj < 2; ++bj) {
                        const int pos = bj ? (s & 63) : (s >> 6);
                        const f32x4 c = *(const f32x4*)(rcc + pos * 16 + 4 * fq), sn = *(const f32x4*)(rcs + pos * 16 + 4 * fq);
                        const f32x4 x1 = acc[ai][bj][m][0] * g4[bj][0] * rstd, x2 = acc[ai][bj][m][1] * g4[bj][1] * rstd;
                        const f32x4 o1 = x1 * c - x2 * sn, o2 = x2 * c + x1 * sn;
                        u32x4 w; w.x = pk2(o1[0], o1[1]); w.y = pk2(o1[2], o1[3]); w.z = pk2(o2[0], o2[1]); w.w = pk2(o2[2], o2[3]);
                        *(u32x4*)(dst + 32 * bj) = w;
                    }
                }
        }
    }
};

struct EpiF {
    bf16_t* F;
    __device__ __forceinline__ void operator()(const f32x4 (&acc)[2][2][4][2], const Unit& uu, int wr, int wc, int fr, int fq) const {
        Unit u = uu; asm volatile("" : "+s"(u.pm), "+s"(u.pn), "+v"(fr), "+v"(fq));
        const int row0 = u.pm * 256 + wr * 64 + fr, col0 = u.pn * 256 + wc * 32 + 8 * fq;
#pragma unroll
        for (int ai = 0; ai < 2; ++ai)
#pragma unroll
            for (int m = 0; m < 4; ++m) {
                bf16_t* rowp = F + (size_t)(row0 + ai * 128 + m * 16) * DM + col0;
#pragma unroll
                for (int bj = 0; bj < 2; ++bj) {
                    const f32x4 v0 = acc[ai][bj][m][0], v1 = acc[ai][bj][m][1];
                    u32x4 w; w.x = pk2(v0[0], v0[1]); w.y = pk2(v0[2], v0[3]); w.z = pk2(v1[0], v1[1]); w.w = pk2(v1[2], v1[3]);
                    *(u32x4*)(rowp + bj * 128) = w;
                }
            }
    }
};

struct EpiGU {
    bf16_t* ACT; float* EP; float* EG; float* EU; const float* cw; const float* cb;
    __device__ __forceinline__ void operator()(const f32x4 (&acc)[2][2][4][2], const Unit& uu, int wr, int wc, int fr, int fq) const {
        Unit u = uu; asm volatile("" : "+s"(u.pm), "+s"(u.pn), "+v"(fr), "+v"(fq));
        const int chan0 = 128 * u.pn + 32 * wc + 8 * fq;
        const int lane = fq * 16 + fr;
        const int srcU = (lane & 48) | ((fr + 15) & 15), srcD = (lane & 48) | ((fr + 1) & 15);
#pragma unroll
        for (int ai = 0; ai < 2; ++ai) {
            const int Rg = u.pm * 256 + 128 * ai + 64 * wr;
            const int gi = Rg >> 6;
#pragma unroll
            for (int n = 0; n < 2; ++n) {
                const f32x4 w0 = *(const f32x4*)(cw + chan0 + 4 * n), w1 = *(const f32x4*)(cw + FF + chan0 + 4 * n), w2 = *(const f32x4*)(cw + 2 * FF + chan0 + 4 * n), bb = *(const f32x4*)(cb + chan0 + 4 * n);
                f32x4 av[4], ptop, pbot;
#pragma unroll
                for (int j = 0; j < 4; ++j) {
                    float gv[4], ru[4], rd[4];
#pragma unroll
                    for (int m = 0; m < 4; ++m) { gv[m] = acc[ai][0][m][n][j]; ru[m] = __shfl(gv[m], srcU); rd[m] = __shfl(gv[m], srcD); }
#pragma unroll
                    for (int m = 0; m < 4; ++m) {
                        const float prev = (fr == 0) ? (m > 0 ? ru[m > 0 ? m - 1 : 0] : 0.f) : ru[m];
                        const float next = (fr == 15) ? (m < 3 ? rd[m < 3 ? m + 1 : 3] : 0.f) : rd[m];
                        const float pre = w0[j] * prev + w1[j] * gv[m] + w2[j] * next + bb[j];
                        av[m][j] = gelu_tanh(pre) * acc[ai][1][m][n][j];
                        if (m == 0) ptop[j] = pre;
                        if (m == 3) pbot[j] = pre;
                    }
                }
                if (fr == 0) { const size_t eo = ((size_t)gi * 2) * FF + chan0 + 4 * n; *(f32x4*)(EP + eo) = ptop; *(f32x4*)(EG + eo) = acc[ai][0][0][n]; *(f32x4*)(EU + eo) = acc[ai][1][0][n]; }
                if (fr == 15) { const size_t eo = ((size_t)gi * 2 + 1) * FF + chan0 + 4 * n; *(f32x4*)(EP + eo) = pbot; *(f32x4*)(EG + eo) = acc[ai][0][3][n]; *(f32x4*)(EU + eo) = acc[ai][1][3][n]; }
#pragma unroll
                for (int m = 0; m < 4; ++m) {
                    const bool edge = ((m == 0) && (fr == 0)) || ((m == 3) && (fr == 15));
                    if (!edge) { u32x2 w; w.x = pk2(av[m][0], av[m][1]); w.y = pk2(av[m][2], av[m][3]); *(u32x2*)(ACT + (size_t)(Rg + 16 * m + fr) * FF + chan0 + 4 * n) = w; }
                }
            }
        }
    }
};

__device__ __forceinline__ int colmap_in(int R) {
    const int T = R >> 8, rt = R & 255, bj = rt >> 7, wc = (rt >> 5) & 3, n = (rt >> 4) & 1, fq = (rt >> 2) & 3, j = rt & 3;
    const int ch = 4 * T + wc;
    const int l = (ch >= 30 && ch < 38) ? (32 * bj + 16 * n + 4 * fq + j) : (32 * bj + 8 * fq + 4 * n + j);
    return 64 * ch + l;
}
template <int MODE>
__device__ __forceinline__ void transpose_item(const Args& a, int layer, int item, LAS float* scr, int lane) {
    constexpr int K = (MODE == 3) ? FF : DM;
    constexpr int NP = (MODE == 0) ? PW : (MODE == 2 ? 2 * FF : DM);
    constexpr int N = (MODE == 0) ? PW : (MODE == 2 ? FF : DM);
    const int nblk = NP / 32, kb = item / nblk, nb = item % nblk, k0 = 64 * kb, n0 = 32 * nb;
    const int R = n0 + (lane & 31);
    const float* src; int col;
    if (MODE == 0) { src = a.in[5] + (size_t)layer * DM * PW; col = colmap_in(R); }
    else if (MODE == 1) { src = a.in[6] + (size_t)layer * DM * DM; col = (R & ~31) + 8 * ((R >> 2) & 3) + 4 * ((R >> 4) & 1) + (R & 3); }
    else if (MODE == 2) {
        const int T = R >> 8, rt = R & 255, bj = rt >> 7, wc = (rt >> 5) & 3, n = (rt >> 4) & 1, fq = (rt >> 2) & 3, j = rt & 3;
        col = 128 * T + 32 * wc + 8 * fq + 4 * n + j; src = (bj ? a.in[20] : a.in[19]) + (size_t)layer * DM * FF;
    } else { src = a.in[23] + (size_t)layer * FF * DM; col = (R & ~31) + 8 * ((R >> 2) & 3) + 4 * ((R >> 4) & 1) + (R & 3); }
    bf16_t* WT = (bf16_t*)(a.ws + (MODE == 0 ? WS_WIN : MODE == 1 ? WS_WOUT : MODE == 2 ? WS_WGU : WS_WDN)) + (size_t)layer * NP * K;
#pragma unroll 8
    for (int i = 0; i < 32; ++i) { const int kk = 2 * i + (lane >> 5); scr[kk * 33 + (lane & 31)] = src[(size_t)(k0 + kk) * N + col]; }
    asm volatile("s_waitcnt lgkmcnt(0)" ::: "memory");
    const int c = lane & 7;
#pragma unroll
    for (int j = 0; j < 4; ++j) {
        const int n = (lane >> 3) + 8 * j; const LAS float* s = scr + (8 * c) * 33 + n;
        u32x4 o; o.x = pk2(s[0 * 33], s[1 * 33]); o.y = pk2(s[2 * 33], s[3 * 33]); o.z = pk2(s[4 * 33], s[5 * 33]); o.w = pk2(s[6 * 33], s[7 * 33]);
        *(u32x4*)(WT + (size_t)(n0 + n) * K + k0 + 8 * c) = o;
    }
    asm volatile("s_waitcnt lgkmcnt(0)" ::: "memory");
}

__device__ __forceinline__ void norm_row(const float* xrow, const float* g, bf16_t* orow, int lane) {
    f32x4 v[4]; float s = 0.f;
#pragma unroll
    for (int j = 0; j < 4; ++j) { v[j] = *(const f32x4*)(xrow + 4 * lane + 256 * j); s += (v[j][0] * v[j][0] + v[j][1] * v[j][1]) + (v[j][2] * v[j][2] + v[j][3] * v[j][3]); }
    const float rstd = rsqrtf(wave_sum(s) * (1.0f / DM) + EPS);
#pragma unroll
    for (int j = 0; j < 4; ++j) {
        const f32x4 gg = *(const f32x4*)(g + 4 * lane + 256 * j); const f32x4 y = v[j] * rstd * gg;
        u32x2 w; w.x = pk2(y[0], y[1]); w.y = pk2(y[2], y[3]); *(u32x2*)(orow + 4 * lane + 256 * j) = w;
    }
}

__device__ __forceinline__ void hyena_raw(const Args& a, int L, int t, LAS float* scr, int lane) {
    const float tl = (float)t * (1.0f / 2047.0f);
    if (lane < 33) {
        float z;
        if (lane == 0) z = tl;
        else {
            const int k = (lane - 1) & 15;
            const float band = 1e-4f + (float)k * ((15.0f - 1e-4f) / 15.0f);
            const float ang = 2.0f * 3.14159265358979323846f * band * (float)t / 2048.0f;
            z = (lane <= 16) ? cosf(ang) : -sinf(ang);
        }
        scr[lane] = z;
    }
    asm volatile("s_waitcnt lgkmcnt(0)" ::: "memory");
    const float* w1 = a.in[11] + L * 33 * 64; const float* b1 = a.in[12] + L * 64; const float* fr = a.in[13] + L * 128;
    const float* w2 = a.in[14] + L * 64 * 64; const float* b2 = a.in[15] + L * 64; const float* w3 = a.in[16] + (size_t)L * 64 * 1024; const float* dec = a.in[17] + L * 1024;
    float h = b1[lane];
    {
        float wv[33];
#pragma unroll
        for (int j = 0; j < 33; ++j) wv[j] = w1[j * 64 + lane];
#pragma unroll
        for (int j = 0; j < 33; ++j) h += scr[j] * wv[j];
    }
    h = sinf(fr[lane] * h);
    scr[64 + lane] = h;
    asm volatile("s_waitcnt lgkmcnt(0)" ::: "memory");
    float h2 = b2[lane];
#pragma unroll 1
    for (int k0 = 0; k0 < 64; k0 += 32) {
        float wv[32];
#pragma unroll
        for (int k = 0; k < 32; ++k) wv[k] = w2[(k0 + k) * 64 + lane];
#pragma unroll
        for (int k = 0; k < 32; ++k) h2 += scr[64 + k0 + k] * wv[k];
    }
    h2 = sinf(fr[64 + lane] * h2);
    scr[128 + lane] = h2;
    asm volatile("s_waitcnt lgkmcnt(0)" ::: "memory");
    float* raw = (float*)(a.ws + WS_HRAW) + ((size_t)L * 2048 + t) * 1024;
    float o[16];
#pragma unroll
    for (int mth = 0; mth < 16; ++mth) o[mth] = 0.f;
#pragma unroll 1
    for (int k0 = 0; k0 < 64; k0 += 4) {
        float wv[4][16];
#pragma unroll
        for (int k = 0; k < 4; ++k)
#pragma unroll
            for (int mth = 0; mth < 16; ++mth) wv[k][mth] = w3[(k0 + k) * 1024 + lane + 64 * mth];
#pragma unroll
        for (int k = 0; k < 4; ++k) { const float hk = scr[128 + k0 + k];
#pragma unroll
            for (int mth = 0; mth < 16; ++mth) o[mth] += hk * wv[k][mth]; }
    }
#pragma unroll
    for (int mth = 0; mth < 16; ++mth) { const int idx = lane + 64 * mth; raw[idx] = o[mth] * expf(-tl * dec[idx]); }
    asm volatile("s_waitcnt lgkmcnt(0)" ::: "memory");
}

__device__ __forceinline__ void phase0(const Args& a, LAS unsigned char* lds) {
    const int tid = tidx(), wid = tid >> 6, lane = tid & 63;
    const int gw = blockIdx.x * 8 + wid, NGW = gridDim.x * 8;
    LAS float* scr = (LAS float*)(lds + wid * 16384);
    for (int i = blockIdx.x * 512 + tid; i < 2048 * 32 + 64 * 16; i += gridDim.x * 512) {
        if (i < 2048 * 32) {
            const int s = i >> 5, d = i & 31; const double f = pow(10000.0, -(double)d / 32.0), ang = (double)s * f;
            ((float*)(a.ws + WS_RAC))[i] = (float)cos(ang); ((float*)(a.ws + WS_RAS))[i] = (float)sin(ang);
        } else {
            const int k = i - 2048 * 32, p = k >> 4, d = k & 15; const double f = pow(10000.0, -(double)d / 16.0), ang = (double)p * f;
            ((float*)(a.ws + WS_RCC))[k] = (float)cos(ang); ((float*)(a.ws + WS_RCS))[k] = (float)sin(ang);
        }
    }
    constexpr int I0 = 16 * 80, I1 = 16 * 32, I2 = 16 * 176, I3 = 44 * 32, IL = I0 + I1 + I2 + I3;
    for (int it = gw; it < 2 * IL; it += NGW) {
        const int layer = it / IL; int r = it % IL;
        if (r < I0) { transpose_item<0>(a, layer, r, scr, lane); continue; } r -= I0;
        if (r < I1) { transpose_item<1>(a, layer, r, scr, lane); continue; } r -= I1;
        if (r < I2) { transpose_item<2>(a, layer, r, scr, lane); continue; } r -= I2;
        transpose_item<3>(a, layer, r, scr, lane);
    }
    for (int it = gw; it < 2 * 2048; it += NGW) hyena_raw(a, it >> 11, it & 2047, scr, lane);
    for (int r = gw * 32; r < MTOK; r += NGW * 32) {
#pragma unroll 1
        for (int k = 0; k < 32; k += 4) {
            f32x4 v[4][4];
#pragma unroll
            for (int u = 0; u < 4; ++u)
#pragma unroll
                for (int j = 0; j < 4; ++j) v[u][j] = *(const f32x4*)(a.in[0] + (size_t)(r + k + u) * DM + 4 * lane + 256 * j);
#pragma unroll
            for (int u = 0; u < 4; ++u) {
                float s = 0.f;
#pragma unroll
                for (int j = 0; j < 4; ++j) s += (v[u][j][0] * v[u][j][0] + v[u][j][1] * v[u][j][1]) + (v[u][j][2] * v[u][j][2] + v[u][j][3] * v[u][j][3]);
                const float rstd = rsqrtf(wave_sum(s) * (1.0f / DM) + EPS);
                bf16_t* orow = (bf16_t*)(a.ws + WS_H) + (size_t)(r + k + u) * DM;
#pragma unroll
                for (int j = 0; j < 4; ++j) { const f32x4 gg = *(const f32x4*)(a.in[1] + 4 * lane + 256 * j); const f32x4 y = v[u][j] * rstd * gg; u32x2 w; w.x = pk2(y[0], y[1]); w.y = pk2(y[2], y[3]); *(u32x2*)(orow + 4 * lane + 256 * j) = w; }
            }
        }
    }
}

__device__ __forceinline__ void gload32(u32x4 (&r)[4], const unsigned char* ubase, unsigned pitch, int lane) {
#pragma unroll
    for (int i = 0; i < 4; ++i) { const unsigned rr = (unsigned)(lane >> 3) + 8u * i; r[i] = *(const u32x4*)(ubase + rr * pitch + (unsigned)(lane & 7) * 16u); }
}
template <bool SWZ>
__device__ __forceinline__ void lwrite32(LAS unsigned char* dst, const u32x4 (&r)[4], int lane) {
#pragma unroll
    for (int i = 0; i < 4; ++i) { const int rr = (lane >> 3) + 8 * i; const int pc = SWZ ? ((lane & 7) ^ ((rr >> 1) & 7)) : (lane & 7); *(LAS u32x4*)(dst + rr * 128 + pc * 16) = r[i]; }
}
__device__ __forceinline__ void load_kf(LAS const unsigned char* kb, bf16x8 (&kf)[4], int lane) {
    const int kl = lane & 31, h = lane >> 5;
#pragma unroll
    for (int s = 0; s < 4; ++s) { const int pc = (2 * s + h) ^ ((kl >> 1) & 7); kf[s] = *(const LAS bf16x8*)(kb + kl * 128 + pc * 16); }
}
__device__ __forceinline__ void load_vf(LAS const unsigned char* vb, bf16x8 (&vf)[2][2], int lane) {
    const int h = lane >> 5, i16 = lane & 15, q = i16 >> 2, p = i16 & 3, dbase = ((lane >> 4) & 1) * 16;
#pragma unroll
    for (int s2 = 0; s2 < 2; ++s2)
#pragma unroll
        for (int dt = 0; dt < 2; ++dt) {
            const int key = 16 * s2 + 4 * h + q, d0 = 32 * dt + dbase + 4 * p;
            const bf16x4 lo = __builtin_amdgcn_ds_read_tr16_b64_v4i16((LAS bf16x4*)(vb + key * 128 + d0 * 2));
            const bf16x4 hi = __builtin_amdgcn_ds_read_tr16_b64_v4i16((LAS bf16x4*)(vb + (key + 8) * 128 + d0 * 2));
            vf[s2][dt] = (bf16x8){lo[0], lo[1], lo[2], lo[3], hi[0], hi[1], hi[2], hi[3]};
        }
}
template <bool KLDS>
__device__ __forceinline__ void attn_step(const bf16x8 (&kf)[4], LAS const unsigned char* kb, const bf16x8 (&vf)[2][2], const bf16x8 (&qf)[4], f32x16& o0, f32x16& o1, float& m, float& l, int lane, int maskmode) {
    const int ql = lane & 31, h = lane >> 5;
    f32x16 S;
#pragma unroll
    for (int i = 0; i < 16; ++i) S[i] = 0.f;
#pragma unroll
    for (int s = 0; s < 4; ++s) {
        if (KLDS) { const int pc = (2 * s + h) ^ ((ql >> 1) & 7); const bf16x8 k1 = *(const LAS bf16x8*)(kb + ql * 128 + pc * 16); S = __builtin_amdgcn_mfma_f32_32x32x16_bf16(k1, qf[s], S, 0, 0, 0); }
        else S = __builtin_amdgcn_mfma_f32_32x32x16_bf16(kf[s], qf[s], S, 0, 0, 0);
    }
    if (maskmode) {
#pragma unroll
        for (int i = 0; i < 16; ++i) { const int kr = (i & 3) + 8 * (i >> 2) + 4 * h; const bool ok = (maskmode == 1) ? (kr >= ql) : (kr <= ql); S[i] = ok ? S[i] : -1e30f; }
    }
    float tm = S[0];
#pragma unroll
    for (int i = 1; i < 16; ++i) tm = fmaxf(tm, S[i]);
    tm = fmaxf(tm, __shfl_xor(tm, 32));
    const float mn = fmaxf(m, tm), al = fexp2(m - mn); m = mn;
    float ps = 0.f;
#pragma unroll
    for (int i = 0; i < 16; ++i) { S[i] = fexp2(S[i] - mn); ps += S[i]; }
    l = l * al + ps;
#pragma unroll
    for (int i = 0; i < 16; ++i) { o0[i] *= al; o1[i] *= al; }
    bf16x8 pf[2];
#pragma unroll
    for (int s2 = 0; s2 < 2; ++s2) {
        u32x4 w; w.x = pk2n(S[8 * s2 + 0], S[8 * s2 + 1]); w.y = pk2n(S[8 * s2 + 2], S[8 * s2 + 3]); w.z = pk2n(S[8 * s2 + 4], S[8 * s2 + 5]); w.w = pk2n(S[8 * s2 + 6], S[8 * s2 + 7]);
        pf[s2] = __builtin_bit_cast(bf16x8, w);
    }
#pragma unroll
    for (int s2 = 0; s2 < 2; ++s2) {
        o0 = __builtin_amdgcn_mfma_f32_32x32x16_bf16(vf[s2][0], pf[s2], o0, 0, 0, 0);
        o1 = __builtin_amdgcn_mfma_f32_32x32x16_bf16(vf[s2][1], pf[s2], o1, 0, 0, 0);
    }
}

__device__ __forceinline__ void attnA_unit(const Args& a, int unit, LAS unsigned char* lds) {
    const int tid = tidx(), wid = __builtin_amdgcn_readfirstlane(tid >> 6), lane = tid & 63, ql = lane & 31, h = lane >> 5;
    const int b = unit / 24, rem = unit % 24, hh = rem >> 2, blk = rem & 3;
    const bf16_t* P = (const bf16_t*)(a.ws + WS_P);
    bf16_t* OA = (bf16_t*)(a.ws + OFF_OA); float* LSE = (float*)(a.ws + OFF_LSE); bf16_t* MIX = (bf16_t*)(a.ws + WS_MIX);
    LAS unsigned char* wl = lds + wid * 8192;
    const unsigned char* kbase = (const unsigned char*)(P + (size_t)b * SEQ * PW + 384 + 64 * hh);
    const unsigned char* vbase = (const unsigned char*)(P + (size_t)b * SEQ * PW + 768 + 64 * hh);
#pragma unroll 1
    for (int pidx = 0; pidx < 3; ++pidx) {
        const int dl = (pidx == 0) ? 1 : (pidx == 1 ? 4 : 16), Ls = SEQ / dl;
        if (pidx == 2) { __syncthreads(); }
#pragma unroll 1
        for (int e = 0; e < 2; ++e) {
            const int qt = 2 * wid + e, r = qt % dl, i0 = (512 * blk) / dl + 32 * (qt / dl);
            const int tq = dl * (i0 + ql) + r;
            bf16x8 qf[4];
            { const bf16_t* qp = P + ((size_t)b * SEQ + tq) * PW + 64 * hh + 8 * h;
#pragma unroll
              for (int s = 0; s < 4; ++s) qf[s] = *(const bf16x8*)(qp + 16 * s); }
            f32x16 o0, o1;
#pragma unroll
            for (int i = 0; i < 16; ++i) { o0[i] = 0.f; o1[i] = 0.f; }
            float m = -1e30f, l = 0.f;
            int kt0 = 0, kt1 = 4;
            if (i0 - 64 < 0) kt0 = (i0 - 32 < 0) ? 2 : 1;
            if (i0 + 64 >= Ls) kt1 = (i0 + 32 >= Ls) ? 2 : 3;
            const unsigned pitch = (unsigned)dl * (PW * 2);
            u32x4 pk[4], pv[4];
            { const size_t ro = (size_t)(dl * (i0 - 64 + 32 * kt0) + r) * (PW * 2); gload32(pk, kbase + ro, pitch, lane); gload32(pv, vbase + ro, pitch, lane); }
#pragma unroll 1
            for (int kt = kt0; kt <= kt1; ++kt) {
                asm volatile("" ::: "memory");
                lwrite32<true>(wl, pk, lane); lwrite32<false>(wl + 4096, pv, lane);
                if (kt < kt1) { const size_t ro = (size_t)(dl * (i0 - 64 + 32 * (kt + 1)) + r) * (PW * 2); gload32(pk, kbase + ro, pitch, lane); gload32(pv, vbase + ro, pitch, lane); }
                asm volatile("s_waitcnt lgkmcnt(0)" ::: "memory");
                bf16x8 kf[4], vf[2][2];
                load_kf(wl, kf, lane); load_vf(wl + 4096, vf, lane);
                attn_step<false>(kf, wl, vf, qf, o0, o1, m, l, lane, kt == 0 ? 1 : (kt == 4 ? 2 : 0));
                asm volatile("" ::: "memory");
            }
            const float lt = l + __shfl_xor(l, 32);
            const float inv = 1.0f / lt, lse = m + __builtin_amdgcn_logf(lt);
            const size_t tokg = (size_t)b * SEQ + tq;
            if (pidx < 2) {
                bf16_t* op = OA + ((size_t)pidx * MTOK + tokg) * 384 + 64 * hh;
#pragma unroll
                for (int dt = 0; dt < 2; ++dt)
#pragma unroll
                    for (int g = 0; g < 4; ++g) {
                        const f32x16& o = dt ? o1 : o0;
                        u32x2 w; w.x = pk2(o[4 * g] * inv, o[4 * g + 1] * inv); w.y = pk2(o[4 * g + 2] * inv, o[4 * g + 3] * inv);
                        *(u32x2*)(op + 32 * dt + 8 * g + 4 * h) = w;
                    }
                if (h == 0) LSE[((size_t)pidx * MTOK + tokg) * 6 + hh] = lse;
            } else {
                const float l1 = LSE[tokg * 6 + hh], l2 = LSE[((size_t)MTOK + tokg) * 6 + hh];
                const float mx = fmaxf(lse, fmaxf(l1, l2));
                const float w1 = fexp2(l1 - mx), w2 = fexp2(l2 - mx), w3 = fexp2(lse - mx);
                const float wi = 1.0f / (w1 + w2 + w3);
                const float c1 = w1 * wi, c2 = w2 * wi, c3 = w3 * wi * inv;
                const bf16_t* p1 = OA + tokg * 384 + 64 * hh; const bf16_t* p2 = OA + ((size_t)MTOK + tokg) * 384 + 64 * hh;
                bf16_t* op = MIX + tokg * DM + 64 * hh;
#pragma unroll
                for (int dt = 0; dt < 2; ++dt)
#pragma unroll
                    for (int g = 0; g < 4; ++g) {
                        const f32x16& o = dt ? o1 : o0;
                        const int d = 32 * dt + 8 * g + 4 * h;
                        const u32x2 a1 = *(const u32x2*)(p1 + d), a2 = *(const u32x2*)(p2 + d);
                        const float r0 = c1 * bflo(a1.x) + c2 * bflo(a2.x) + c3 * o[4 * g], r1 = c1 * bfhi(a1.x) + c2 * bfhi(a2.x) + c3 * o[4 * g + 1];
                        const float r2 = c1 * bflo(a1.y) + c2 * bflo(a2.y) + c3 * o[4 * g + 2], r3 = c1 * bfhi(a1.y) + c2 * bfhi(a2.y) + c3 * o[4 * g + 3];
                        u32x2 w; w.x = pk2(r0, r1); w.y = pk2(r2, r3);
                        *(u32x2*)(op + d) = w;
                    }
            }
        }
    }
}

__device__ __forceinline__ void attnC_unit(const Args& a, int unit, LAS unsigned char* lds) {
    const int tid = tidx(), wid = __builtin_amdgcn_readfirstlane(tid >> 6), lane = tid & 63, ql = lane & 31, h = lane >> 5;
    const int b = unit / 24, rem = unit % 24, hq = rem >> 2, qb = rem & 3, g = hq / 3;
    const bf16_t* P = (const bf16_t*)(a.ws + WS_P);
    bf16_t* MIX = (bf16_t*)(a.ws + WS_MIX);
    const int srow = tid >> 3, sch = tid & 7;
    const unsigned char* kg = (const unsigned char*)(P + ((size_t)b * SEQ + srow) * PW + CK0 + 64 * g) + sch * 16;
    const unsigned char* vg = (const unsigned char*)(P + ((size_t)b * SEQ + srow) * PW + CV0 + 64 * g) + sch * 16;
    const int kwo = srow * 128 + ((sch ^ ((srow >> 1) & 7)) * 16), vwo = 8192 + srow * 128 + sch * 16;
    const size_t tok0 = (size_t)b * SEQ + 512 * qb + 64 * wid + ql;
    bf16x8 qf[2][4]; f32x16 o0[2], o1[2]; float m[2], l[2];
#pragma unroll
    for (int e = 0; e < 2; ++e) {
        const bf16_t* qp = P + (tok0 + 32 * e) * PW + CQ0 + 64 * hq + 8 * h;
#pragma unroll
        for (int s = 0; s < 4; ++s) qf[e][s] = *(const bf16x8*)(qp + 16 * s);
#pragma unroll
        for (int i = 0; i < 16; ++i) { o0[e][i] = 0.f; o1[e][i] = 0.f; }
        m[e] = -1e30f; l[e] = 0.f;
    }
    constexpr size_t TSTEP = (size_t)64 * PW * 2;
    u32x4 rk = *(const u32x4*)kg, rv = *(const u32x4*)vg;
    __syncthreads();
    *(LAS u32x4*)(lds + kwo) = rk; *(LAS u32x4*)(lds + vwo) = rv;
    rk = *(const u32x4*)(kg + TSTEP); rv = *(const u32x4*)(vg + TSTEP);
    __syncthreads();
#pragma unroll 1
    for (int kt = 0; kt < 32; ++kt) {
        LAS unsigned char* cur = lds + (kt & 1) * 16384;
        LAS unsigned char* nxt = lds + ((kt + 1) & 1) * 16384;
        if (kt + 1 < 32) { *(LAS u32x4*)(nxt + kwo) = rk; *(LAS u32x4*)(nxt + vwo) = rv; }
        if (kt + 2 < 32) { rk = *(const u32x4*)(kg + (size_t)(kt + 2) * TSTEP); rv = *(const u32x4*)(vg + (size_t)(kt + 2) * TSTEP); }
#pragma unroll
        for (int j = 0; j < 2; ++j) {
            bf16x8 kf[4], vf[2][2];
            load_kf(cur + j * 4096, kf, lane); load_vf(cur + 8192 + j * 4096, vf, lane);
#pragma unroll
            for (int e = 0; e < 2; ++e) attn_step<false>(kf, cur, vf, qf[e], o0[e], o1[e], m[e], l[e], lane, 0);
        }
        __syncthreads();
    }
#pragma unroll
    for (int e = 0; e < 2; ++e) {
        const float lt = l[e] + __shfl_xor(l[e], 32), inv = 1.0f / lt;
        bf16_t* op = MIX + (tok0 + 32 * e) * DM + 640 + 64 * hq;
#pragma unroll
        for (int dt = 0; dt < 2; ++dt)
#pragma unroll
            for (int gg = 0; gg < 4; ++gg) {
                const f32x16& oo = dt ? o1[e] : o0[e];
                u32x2 w; w.x = pk2(oo[4 * gg] * inv, oo[4 * gg + 1] * inv); w.y = pk2(oo[4 * gg + 2] * inv, oo[4 * gg + 3] * inv);
                *(u32x2*)(op + 32 * dt + 8 * gg + 4 * h) = w;
            }
    }
}

constexpr int HY_CP = 8192 + 16;
__device__ __forceinline__ void hy_filter(const Args& a, int L, int order, int c, LAS unsigned char* lds) {
    const int tid = tidx();
    LAS float* tmp = (LAS float*)(lds + 66048);
    LAS float* red = (LAS float*)(lds + 66048 + 16384);
    const float* raw = (const float*)(a.ws + WS_HRAW) + (size_t)L * 2048 * 1024 + order * 512 + c;
    float s = 0.f;
    for (int i = tid; i < 4096; i += 512) {
        float v;
        if (i < 2048) v = raw[(size_t)i * 1024];
        else if (i == 2048) v = 0.f;
        else v = raw[(size_t)(4096 - i) * 1024 + 256];
        tmp[i] = v; s += fabsf(v);
    }
    s = wave_sum(s);
    if ((tid & 63) == 0) red[tid >> 6] = s;
    __syncthreads();
    float tot = 0.f;
#pragma unroll
    for (int w = 0; w < 8; ++w) tot += red[w];
    const float inv = 1.0f / tot;
    for (int i = tid; i < 8 * 4096; i += 512) {
        const int q = i >> 12, x = i & 4095;
        const float v = tmp[(q - x) & 4095] * inv;
        *(LAS bf16_t*)(lds + q * HY_CP + x * 2) = (bf16_t)(pk2(v, 0.f) & 0xffffu);
    }
    __syncthreads();
}
template <int EPI>
__device__ __forceinline__ void hy_conv(const Args& a, int L, int c, const bf16_t* U, LAS unsigned char* lds) {
    const int tid = tidx(), wid = tid >> 6, lane = tid & 63, n = lane & 31, h = lane >> 5;
    const bf16_t* UC = (const bf16_t*)(a.ws + OFF_UC);
    bf16_t* Z = (bf16_t*)(a.ws + OFF_Z) + (size_t)c * MTOK;
    bf16_t* MIX = (bf16_t*)(a.ws + WS_MIX);
    const float dbias = a.in[18][L * 512 + EPI * 256 + c];
    const bf16_t* urow = U + (size_t)n * SEQ + 8 * h;
    LAS const unsigned char* fbase = lds + (n & 7) * HY_CP;
    const int foff = 8 * h - (n & ~7);
#pragma unroll 1
    for (int blk = 0; blk < 2; ++blk) {
        const int tb = 8 * wid + 4 * blk;
        f32x16 acc[4];
#pragma unroll
        for (int tt = 0; tt < 4; ++tt)
#pragma unroll
            for (int i = 0; i < 16; ++i) acc[tt][i] = 0.f;
        bf16x8 an[4];
#pragma unroll
        for (int k = 0; k < 4; ++k) an[k] = *(const bf16x8*)(urow + 16 * k);
#pragma unroll 1
        for (int s0 = 0; s0 < SEQ; s0 += 64) {
            bf16x8 ac[4];
#pragma unroll
            for (int k = 0; k < 4; ++k) ac[k] = an[k];
            if (s0 + 64 < SEQ) {
#pragma unroll
                for (int k = 0; k < 4; ++k) an[k] = *(const bf16x8*)(urow + s0 + 64 + 16 * k);
            }
            bf16x8 bfr[10];
            const int D0 = s0 - 32 * tb + foff;
#pragma unroll
            for (int d = 0; d < 10; ++d) { const int x = (D0 + 16 * (d - 6)) & 4095; bfr[d] = *(const LAS bf16x8*)(fbase + x * 2); }
#pragma unroll
            for (int k = 0; k < 4; ++k)
#pragma unroll
                for (int tt = 0; tt < 4; ++tt) acc[tt] = __builtin_amdgcn_mfma_f32_32x32x16_bf16(ac[k], bfr[k - 2 * tt + 6], acc[tt], 0, 0, 0);
        }
#pragma unroll
        for (int tt = 0; tt < 4; ++tt)
#pragma unroll
            for (int i = 0; i < 16; ++i) {
                const int bb = (i & 3) + 8 * (i >> 2) + 4 * h, t = 32 * (tb + tt) + n;
                const size_t tok = (size_t)bb * SEQ + t;
                if (EPI == 0) {
                    const float v = bf2f(UC[(size_t)c * MTOK + tok]), x1 = bf2f(UC[((size_t)256 + c) * MTOK + tok]);
                    const float z = x1 * (acc[tt][i] + dbias * v);
                    Z[tok] = (bf16_t)(pk2(z, 0.f) & 0xffffu);
                } else {
                    const float zz = bf2f(Z[tok]), x2 = bf2f(UC[((size_t)512 + c) * MTOK + tok]);
                    const float o = x2 * (acc[tt][i] + dbias * zz);
                    MIX[tok * DM + 384 + c] = (bf16_t)(pk2(o, 0.f) & 0xffffu);
                }
            }
    }
}
__device__ __forceinline__ void hyena_unit(const Args& a, int L, int c, LAS unsigned char* lds) {
    const int tid = tidx();
    const bf16_t* UT = (const bf16_t*)(a.ws + OFF_UT);
    bf16_t* UC = (bf16_t*)(a.ws + OFF_UC);
    const float* cwp = a.in[9] + L * 3 * 768; const float* cbp = a.in[10] + L * 768;
#pragma unroll 1
    for (int k3 = 0; k3 < 3; ++k3) {
        const int hc = 256 * k3 + c;
        const float w0 = cwp[hc], w1 = cwp[768 + hc], w2 = cwp[1536 + hc], bb = cbp[hc];
        const bf16_t* src = UT + (size_t)hc * MTOK; bf16_t* dst = UC + (size_t)hc * MTOK;
        for (int ck = tid; ck < MTOK / 8; ck += 512) {
            const int t0 = ck * 8, s = t0 & 2047;
            const u32x4 v = *(const u32x4*)(src + t0);
            float x[10];
            x[0] = (s == 0) ? 0.f : bf2f(src[t0 - 1]);
            x[1] = bflo(v.x); x[2] = bfhi(v.x); x[3] = bflo(v.y); x[4] = bfhi(v.y); x[5] = bflo(v.z); x[6] = bfhi(v.z); x[7] = bflo(v.w); x[8] = bfhi(v.w);
            x[9] = (s == 2040) ? 0.f : bf2f(src[t0 + 8]);
            float y[8];
#pragma unroll
            for (int j = 0; j < 8; ++j) y[j] = w0 * x[j] + w1 * x[j + 1] + w2 * x[j + 2] + bb;
            u32x4 o; o.x = pk2(y[0], y[1]); o.y = pk2(y[2], y[3]); o.z = pk2(y[4], y[5]); o.w = pk2(y[6], y[7]);
            *(u32x4*)(dst + t0) = o;
        }
    }
    __syncthreads();
    hy_filter(a, L, 0, c, lds);
    hy_conv<0>(a, L, c, UC + (size_t)c * MTOK, lds);
    __syncthreads();
    hy_filter(a, L, 1, c, lds);
    hy_conv<1>(a, L, c, (const bf16_t*)(a.ws + OFF_Z) + (size_t)c * MTOK, lds);
    __syncthreads();
}

__device__ __forceinline__ void row_pass(const bf16_t* F, const float* xold, float* xnew, const float* gpost, const float* gnext, bf16_t* H, int G, int c) {
    const int tid = tidx(), wid = tid >> 6; int lane = tid & 63; asm volatile("" : "+v"(lane));
    f32x4 gp[4], gn[4];
#pragma unroll
    for (int j = 0; j < 4; ++j) { gp[j] = *(const f32x4*)(gpost + 4 * lane + 256 * j); gn[j] = gnext ? *(const f32x4*)(gnext + 4 * lane + 256 * j) : (f32x4){0.f, 0.f, 0.f, 0.f}; }
    for (int rb = (c * 8 + wid) * 32; rb < MTOK; rb += G * 8 * 32) {
#pragma unroll 1
        for (int k = 0; k < 32; k += 4) {
            u32x2 fw[4][4]; f32x4 x[4][4];
#pragma unroll
            for (int u = 0; u < 4; ++u) {
                const size_t ro = (size_t)(rb + k + u) * DM + 4 * lane;
#pragma unroll
                for (int j = 0; j < 4; ++j) { fw[u][j] = *(const u32x2*)(F + ro + 256 * j); x[u][j] = *(const f32x4*)(xold + ro + 256 * j); }
            }
#pragma unroll
            for (int u = 0; u < 4; ++u) {
                const size_t ro = (size_t)(rb + k + u) * DM + 4 * lane;
                f32x4 f[4]; float s = 0.f;
#pragma unroll
                for (int j = 0; j < 4; ++j) { f[j] = (f32x4){bflo(fw[u][j].x), bfhi(fw[u][j].x), bflo(fw[u][j].y), bfhi(fw[u][j].y)}; s += (f[j][0] * f[j][0] + f[j][1] * f[j][1]) + (f[j][2] * f[j][2] + f[j][3] * f[j][3]); }
                const float rstd = rsqrtf(wave_sum(s) * (1.0f / DM) + EPS);
                float s2 = 0.f;
#pragma unroll
                for (int j = 0; j < 4; ++j) { x[u][j] = x[u][j] + f[j] * rstd * gp[j]; *(f32x4*)(xnew + ro + 256 * j) = x[u][j]; s2 += (x[u][j][0] * x[u][j][0] + x[u][j][1] * x[u][j][1]) + (x[u][j][2] * x[u][j][2] + x[u][j][3] * x[u][j][3]); }
                if (gnext) {
                    const float rstd2 = rsqrtf(wave_sum(s2) * (1.0f / DM) + EPS);
#pragma unroll
                    for (int j = 0; j < 4; ++j) { const f32x4 y = x[u][j] * rstd2 * gn[j]; u32x2 w; w.x = pk2(y[0], y[1]); w.y = pk2(y[2], y[3]); *(u32x2*)(H + ro + 256 * j) = w; }
                }
            }
        }
    }
}

__device__ __forceinline__ void ffn_fixup(const Args& a, int L, int panel) {
    const float* EP = (const float*)(a.ws + OFF_EP); const float* EG = (const float*)(a.ws + OFF_EG); const float* EU = (const float*)(a.ws + OFF_EU);
    bf16_t* ACT = (bf16_t*)(a.ws + WS_P);
    const float* cw = a.in[21] + (size_t)L * 3 * FF;
    int tid0 = tidx(); asm volatile("" : "+v"(tid0));
    for (int i = tid0; i < 8 * FF; i += 512) {
        const int e = i / FF, c = i % FF, gi = 4 * panel + (e >> 1), side = e & 1;
        const int row = 64 * gi + (side ? 63 : 0);
        const size_t eo = ((size_t)gi * 2 + side) * FF + c;
        float nb = 0.f, w;
        if (side == 0) { w = cw[c]; if ((row & 2047) != 0) nb = EG[((size_t)(gi - 1) * 2 + 1) * FF + c]; }
        else { w = cw[2 * FF + c]; if ((row & 2047) != 2047) nb = EG[((size_t)(gi + 1) * 2) * FF + c]; }
        const float pre = EP[eo] + w * nb;
        const float act = gelu_tanh(pre) * EU[eo];
        ACT[(size_t)row * FF + c] = (bf16_t)(pk2(act, 0.f) & 0xffffu);
    }
}

__device__ __forceinline__ void run_phase(const Args& a0, int ph, LAS unsigned char* lds) {
    Args a = a0;
#pragma unroll
    for (int i = 0; i < 24; ++i) { const __attribute__((address_space(1))) float* p = (const __attribute__((address_space(1))) float*)a0.in[i]; asm volatile("" : "+s"(p)); a.in[i] = (const float*)p; }
    { __attribute__((address_space(1))) float* p = (__attribute__((address_space(1))) float*)a0.out; asm volatile("" : "+s"(p)); a.out = (float*)p; }
    { __attribute__((address_space(1))) unsigned char* p = (__attribute__((address_space(1))) unsigned char*)a0.ws; asm volatile("" : "+s"(p)); a.ws = (unsigned char*)p; }
    int G = gridDim.x, c = blockIdx.x; asm volatile("" : "+s"(G), "+s"(c));
#ifndef PHM
#define PHM 63
#endif
    if (ph == 0) { for (int rep = 0; rep < NREP(32); ++rep) { phase0(a, lds); __syncthreads(); } return; }
    const int L = (ph - 1) / 7, sub = (ph - 1) % 7;
    bf16_t* H = (bf16_t*)(a.ws + WS_H);
    bf16_t* Fb = (bf16_t*)(a.ws + WS_F);
    if (sub == 0) {
        pg8::Gemm g{H, (const bf16_t*)(a.ws + WS_WIN) + (size_t)L * PW * DM, MTOK, PW, DM};
        pg8::StaticOrder S; S.init(MTOK, PW, G, c);
        EpiIn E{(bf16_t*)(a.ws + WS_P), (bf16_t*)(a.ws + OFF_UT), (const float*)(a.ws + WS_RAC), (const float*)(a.ws + WS_RAS), (const float*)(a.ws + WS_RCC), (const float*)(a.ws + WS_RCS),
                a.in[7] + L * 64, a.in[8] + L * 64, lds + 131072};
        for (int rep = 0; rep < NREP(8); ++rep) pg8::gemm_phase(lds, g, S, E);
    } else if (sub == 1) {
        for (int rep = 0; rep < NREP(1); ++rep) for (int ch = c; ch < 256; ch += G) hyena_unit(a, L, ch, lds);
        for (int rep = 0; rep < NREP(2); ++rep) for (int u = c; u < 768; u += G) attnC_unit(a, u, lds);
        for (int rep = 0; rep < NREP(4); ++rep) { __syncthreads(); for (int u = c; u < 768; u += G) { attnA_unit(a, u, lds); __syncthreads(); } }
    } else if (sub == 2) {
        pg8::Gemm g{(const bf16_t*)(a.ws + WS_MIX), (const bf16_t*)(a.ws + WS_WOUT) + (size_t)L * DM * DM, MTOK, DM, DM};
        pg8::StaticOrder S; S.init(MTOK, DM, G, c); EpiF E{Fb};
        for (int rep = 0; rep < NREP(64); ++rep) pg8::gemm_phase(lds, g, S, E);
    } else if (sub == 3) {
        row_pass(Fb, L == 0 ? a.in[0] : a.out, a.out, a.in[2] + L * DM, a.in[3] + L * DM, H, G, c);
    } else if (sub == 4) {
        pg8::Gemm g{H, (const bf16_t*)(a.ws + WS_WGU) + (size_t)L * 2 * FF * DM, MTOK, 2 * FF, DM};
        pg8::StaticOrder S; S.init(MTOK, 2 * FF, G, c);
        EpiGU E{(bf16_t*)(a.ws + WS_P), (float*)(a.ws + OFF_EP), (float*)(a.ws + OFF_EG), (float*)(a.ws + OFF_EU), a.in[21] + (size_t)L * 3 * FF, a.in[22] + (size_t)L * FF};
        for (int rep = 0; rep < NREP(16); ++rep) pg8::gemm_phase(lds, g, S, E);
    } else if (sub == 5) {
        pg8::Gemm g{(const bf16_t*)(a.ws + WS_P), (const bf16_t*)(a.ws + WS_WDN) + (size_t)L * DM * FF, MTOK, DM, FF};
        pg8::StaticOrder S; S.init(MTOK, DM, G, c); EpiF E{Fb};
        { Unit u; int last = -1; for (int i = 0; S.next(i, u); ++i) if (u.pm != last) { ffn_fixup(a, L, u.pm); last = u.pm; } }
        __syncthreads();
        pg8::gemm_phase(lds, g, S, E);
    } else {
        row_pass(Fb, a.out, a.out, a.in[4] + L * DM, L == 0 ? a.in[1] + DM : nullptr, H, G, c);
    }
}

#define XB_TMO      128
#define XB_XCNT(j)  (256  + 64 * (j))
#define XB_XSUB(j)  (1280 + 64 * (j))
#define XB_XGEN(j)  (2304 + 64 * (j))
#define XB_TOP      3328
#define XB_TOPGEN   3392
#define XB_SPIN_CAP (1u << 22)
__device__ __forceinline__ unsigned xb_ld(unsigned* p)              { return __hip_atomic_load(p, __ATOMIC_RELAXED, __HIP_MEMORY_SCOPE_AGENT); }
__device__ __forceinline__ unsigned xb_add(unsigned* p, unsigned v) { return __hip_atomic_fetch_add(p, v, __ATOMIC_RELAXED, __HIP_MEMORY_SCOPE_AGENT); }
__device__ __forceinline__ unsigned xb_xcc_id() { return (unsigned)__builtin_amdgcn_s_getreg((3 << 11) | 20) & 0xFu; }
#define XB_SPIN(cond, bar) do { unsigned _sp = 0; while (cond) { __builtin_amdgcn_s_sleep(1); \
    if ((++_sp & 255u) == 0u) { if (xb_ld(&(bar)[XB_TMO])) break; if (_sp > XB_SPIN_CAP) { atomicAdd(&(bar)[XB_TMO], 1u); break; } } } } while (0)
struct XbCensus { unsigned nloc, nx; };
__device__ __forceinline__ XbCensus xcd_barrier_complete(unsigned* bar, unsigned x) {
    const unsigned G = gridDim.x;
    unsigned sum, cnt, mine, sp = 0u;
    for (;;) {
        sum = 0u; cnt = 0u; mine = 0u;
#pragma unroll
        for (unsigned j = 0; j < 16; ++j) { const unsigned c = xb_ld(&bar[XB_XCNT(j)]); sum += c; cnt += (c > 0u) ? 1u : 0u; mine = (j == x) ? c : mine; }
        if (sum == G) break;
        __builtin_amdgcn_s_sleep(1);
        if ((++sp & 255u) == 0u) { if (xb_ld(&bar[XB_TMO])) break; if (sp > XB_SPIN_CAP) { atomicAdd(&bar[XB_TMO], 1u); break; } }
    }
    XbCensus r; r.nloc = mine > 0u ? mine : 1u; r.nx = cnt > 0u ? cnt : 1u; return r;
}
__device__ __forceinline__ void xcd_barrier(unsigned* bar, unsigned x, bool first) {
    asm volatile("s_waitcnt vmcnt(0)" ::: "memory");
    __syncthreads();
    if (threadIdx.x == 0) {
        __builtin_amdgcn_s_waitcnt(0);
        unsigned* slot = bar + 4096 + 2 * blockIdx.x;
        XbCensus cs;
        if (first) { cs = xcd_barrier_complete(bar, x); slot[0] = cs.nloc; slot[1] = cs.nx; }
        else { cs.nloc = xb_ld(slot); cs.nx = xb_ld(slot + 1); }
        const unsigned nloc = cs.nloc, nx = cs.nx;
        const unsigned old = xb_add(&bar[XB_XSUB(x)], 1u);
        const unsigned gen = old / nloc;
        if (old + 1u == (gen + 1u) * nloc) {
            __builtin_amdgcn_fence(__ATOMIC_RELEASE, "agent");
            asm volatile("s_waitcnt vmcnt(0)" ::: "memory");
            const unsigned og = xb_add(&bar[XB_TOP], 1u);
            const unsigned tg = og / nx;
            if (og + 1u == (tg + 1u) * nx) xb_add(&bar[XB_TOPGEN], 1u);
            else XB_SPIN(xb_ld(&bar[XB_TOPGEN]) == tg, bar);
            __builtin_amdgcn_fence(__ATOMIC_ACQUIRE, "agent");
            xb_add(&bar[XB_XGEN(x)], 1u);
            asm volatile("s_waitcnt vmcnt(0)" ::: "memory");
        } else {
            XB_SPIN(xb_ld(&bar[XB_XGEN(x)]) == gen, bar);
            __builtin_amdgcn_fence(__ATOMIC_ACQUIRE, "agent");
            asm volatile("s_waitcnt vmcnt(0)" ::: "memory");
        }
    }
    __syncthreads();
}

__global__ __launch_bounds__(512, 2) void mk_fwd(Args a) {
    extern __shared__ __attribute__((aligned(16))) unsigned char lds_raw[];
    LAS unsigned char* lds = (LAS unsigned char*)lds_raw;
    unsigned* bar = (unsigned*)a.ws;
    unsigned xcc = 0u;
    if (a.coop) { xcc = xb_xcc_id(); if (threadIdx.x == 0) (void)xb_add(&bar[XB_XCNT(xcc)], 1u); }
    (void)xcc;
    for (int ph = a.ph_lo; ph < a.ph_hi; ++ph) {
        run_phase(a, ph, lds);
        if (a.coop && ph + 1 < a.ph_hi) {
            if (ph == 0) cg::this_grid().sync();
            else xcd_barrier(bar, xb_xcc_id(), ph == 1);
        }
    }
}

extern "C" void kernel_launch(void* const* d_in, const int* in_sizes, int n_in, void* d_out, int out_size, void* d_ws, size_t ws_size, hipStream_t stream) {
    static int grid = 0;
    if (grid == 0) {
        if (n_in != 24 || out_size != MTOK * DM || ws_size < WS_END) { fprintf(stderr, "kernel_launch: unexpected shapes / workspace (n_in %d out %d ws %zu need %zu)\n", n_in, out_size, ws_size, (size_t)WS_END); grid = -1; return; }
        int dev = 0, cus = 0, per_cu = 0;
        hipGetDevice(&dev); hipDeviceGetAttribute(&cus, hipDeviceAttributeMultiprocessorCount, dev);
        if (hipFuncSetAttribute((const void*)mk_fwd, hipFuncAttributeMaxDynamicSharedMemorySize, LDS_BYTES) != hipSuccess) { fprintf(stderr, "kernel_launch: hipFuncSetAttribute failed\n"); grid = -1; return; }
        if (hipOccupancyMaxActiveBlocksPerMultiprocessor(&per_cu, (const void*)mk_fwd, 512, LDS_BYTES) != hipSuccess || per_cu < 1) { fprintf(stderr, "kernel_launch: occupancy query says %d\n", per_cu); per_cu = 1; }
        (void)hipGetLastError();
        grid = cus;
    }
    if (grid < 0) return;
    if (hipMemsetAsync(d_ws, 0, 32768, stream) != hipSuccess) { fprintf(stderr, "kernel_launch: memset of the barrier words failed\n"); return; }
    Args a{};
    for (int i = 0; i < 24; ++i) a.in[i] = (const float*)d_in[i];
    a.out = (float*)d_out; a.ws = (unsigned char*)d_ws;
#if MK_COOP
    a.ph_lo = 0; a.ph_hi = NPH; a.coop = 1;
    void* args[] = {&a};
    hipError_t e = hipLaunchCooperativeKernel((const void*)mk_fwd, dim3(grid), dim3(512), args, LDS_BYTES, stream);
    if (e != hipSuccess) fprintf(stderr, "cooperative launch failed: %s (grid %d)\n", hipGetErrorString(e), grid);
#else
    for (int ph = 0; ph < NPH; ++ph) {
        a.ph_lo = ph; a.ph_hi = ph + 1; a.coop = 0;
        hipLaunchKernelGGL(mk_fwd, dim3(grid), dim3(512), LDS_BYTES, stream, a);
    }
#endif
}
```

```cpp
#include <hip/hip_runtime.h>
#include <hip/hip_cooperative_groups.h>
#include <cstdio>
namespace cg = cooperative_groups;

#ifndef NPH
#define NPH 15
#endif
#ifndef REPM
#define REPM 0
#endif
#define NREP(bit) ((REPM & (bit)) ? 2 : 1)
#ifndef MK_COOP
#define MK_COOP 1
#endif

#define LAS __attribute__((address_space(3)))
typedef unsigned short bf16_t;
typedef short bf16x8 __attribute__((ext_vector_type(8)));
typedef short bf16x4 __attribute__((ext_vector_type(4)));
typedef float f32x4 __attribute__((ext_vector_type(4)));
typedef float f32x16 __attribute__((ext_vector_type(16)));
typedef unsigned u32x4 __attribute__((ext_vector_type(4)));
typedef unsigned u32x2 __attribute__((ext_vector_type(2)));

constexpr int NB = 32, SEQ = 2048, DM = 1024, MTOK = NB * SEQ, PW = 2560, FF = 2816;
constexpr int CQ0 = 1920, CK0 = 2304, CV0 = 2432;
constexpr float LOG2E = 1.4426950408889634f;
constexpr float EPS = 1e-6f;

constexpr size_t WS_RAC = 32768;
constexpr size_t WS_RAS = WS_RAC + 2048 * 32 * 4;
constexpr size_t WS_RCC = WS_RAS + 2048 * 32 * 4;
constexpr size_t WS_RCS = WS_RCC + 64 * 16 * 4;
constexpr size_t WS_WIN = WS_RCS + 64 * 16 * 4;
constexpr size_t WS_WOUT = WS_WIN + 2ull * 2560 * 1024 * 2;
constexpr size_t WS_WGU = WS_WOUT + 2ull * 1024 * 1024 * 2;
constexpr size_t WS_WDN = WS_WGU + 2ull * 5632 * 1024 * 2;
constexpr size_t WS_HRAW = WS_WDN + 2ull * 1024 * 2816 * 2;
constexpr size_t WS_H = WS_HRAW + 2ull * 2048 * 1024 * 4;
constexpr size_t WS_P = WS_H + (size_t)MTOK * 1024 * 2;
constexpr size_t WS_MIX = WS_P + (size_t)MTOK * 2816 * 2;
constexpr size_t WS_F = WS_MIX + (size_t)MTOK * 1024 * 2;
constexpr size_t WS_END = WS_F + (size_t)MTOK * 1024 * 4;
constexpr size_t OFF_UC = WS_H, OFF_Z = WS_H + 3ull * 256 * MTOK * 2;
constexpr size_t OFF_UT = WS_F, OFF_OA = WS_F + 768ull * MTOK * 2, OFF_LSE = OFF_OA + 2ull * MTOK * 384 * 2;
constexpr size_t EDGE_SZ = 1024ull * 2 * FF * 4;
constexpr size_t OFF_EP = WS_MIX, OFF_EG = WS_MIX + EDGE_SZ, OFF_EU = WS_MIX + 2 * EDGE_SZ;
constexpr int LDS_BYTES = 163840;

struct Args { const float* in[24]; float* out; unsigned char* ws; int ph_lo, ph_hi, coop, pad; };

__device__ __forceinline__ int tidx() { int t = threadIdx.x; asm volatile("" : "+v"(t)); return t; }
__device__ __forceinline__ unsigned pk2(float lo, float hi) { unsigned r; asm("v_cvt_pk_bf16_f32 %0, %1, %2" : "=v"(r) : "v"(lo), "v"(hi)); return r; }
typedef float f32x2v __attribute__((ext_vector_type(2)));
typedef __bf16 bf16v2 __attribute__((ext_vector_type(2)));
__device__ __forceinline__ unsigned pk2n(float lo, float hi) { const f32x2v v = {lo, hi}; const bf16v2 b = __builtin_convertvector(v, bf16v2); return __builtin_bit_cast(unsigned, b); }
__device__ __forceinline__ float bf2f(bf16_t b) { return __uint_as_float(((unsigned)b) << 16); }
__device__ __forceinline__ float bflo(unsigned w) { return __uint_as_float(w << 16); }
__device__ __forceinline__ float bfhi(unsigned w) { return __uint_as_float(w & 0xffff0000u); }
__device__ __forceinline__ float wave_sum(float v) {
#pragma unroll
    for (int o = 1; o < 64; o <<= 1) v += __shfl_xor(v, o);
    return v;
}
__device__ __forceinline__ float fexp2(float x) { return __builtin_amdgcn_exp2f(x); }
__device__ __forceinline__ float gelu_tanh_mul(float x, float up) {
    constexpr float C1 = -2.0f * 0.7978845608028654f * LOG2E, C3 = C1 * 0.044715f;
    const float p = __builtin_fmaf(x * x, C3, C1);
    const float e = fexp2(x * p);
    return (x * up) * __builtin_amdgcn_rcpf(1.0f + e);
}
__device__ __forceinline__ float gelu_tanh(float x) {
    const float u = x * (1.0f + 0.044715f * x * x);
    const float e = fexp2(-2.0f * 0.7978845608028654f * LOG2E * u);
    return x * __builtin_amdgcn_rcpf(1.0f + e);
}

namespace pg8 {
constexpr int BM = 256, BK = 64, HALF = 128, HTB = HALF * BK * 2, STAGE_BYTES = 8 * HTB, NXCD = 8, WGM = 8;
__device__ __forceinline__ int lds_byte(int r, int c) { const int st = (r >> 4) * 2 + (c >> 5), rr = r & 15, cc = c & 31, ob = rr * 64 + cc * 2; return st * 1024 + (ob ^ (((ob >> 9) & 1) << 5)); }
__device__ __forceinline__ void stage_rc(int b, int& R, int& C) { const int st = b / 1024, sb = b % 1024, swz = sb ^ (((sb >> 9) & 1) << 5); R = (st >> 1) * 16 + swz / 64; C = (st & 1) * 32 + (swz % 64) / 2; }
struct Unit { int pm, pn; };
struct Gemm { const bf16_t* A; const bf16_t* Bt; int M, N, K; };
struct StaticOrder {
    int nM, nN, nwg, G, c;
    __device__ void init(int M, int N, int G_, int c_) { nM = M / BM; nN = N / BM; nwg = nM * nN; G = G_; c = c_; }
    __device__ __forceinline__ bool next(int i, Unit& u) const {
        const long L = (long)i * G + c; if (L >= nwg) return false;
        int wgid = (int)L; { const int q = nwg / NXCD, r = nwg % NXCD, xcd = wgid % NXCD, off = wgid / NXCD; wgid = (xcd < r ? xcd * (q + 1) : r * (q + 1) + (xcd - r) * q) + off; }
        const int nig = WGM * nN, gid = wgid / nig, fm = gid * WGM, gsz = (nM - fm) < WGM ? (nM - fm) : WGM;
        u.pm = fm + ((wgid % nig) % gsz); u.pn = (wgid % nig) / gsz; return true;
    }
};
struct PanelOrder {
    int pm;
    __device__ __forceinline__ bool next(int i, Unit& u) const { if (i >= 4) return false; u.pm = pm; u.pn = i; return true; }
};

template <class Epi, class Sched>
__device__ __forceinline__ void gemm_phase(LAS unsigned char* lds, const Gemm g, const Sched& S, const Epi& E) {
    const int tid = tidx(), wid = __builtin_amdgcn_readfirstlane(tid >> 6), lane = tid & 63, wr = wid >> 2, wc = wid & 3, fr = lane & 15, fq = lane >> 4;
    const int K = g.K, nt = K / BK;
    unsigned voffA[2], voffB[2];
#pragma unroll
    for (int i = 0; i < 2; ++i) { int R, C; stage_rc(tid * 16 + i * 8192, R, C); voffA[i] = (unsigned)(R * K + C) * 2u; voffB[i] = voffA[i]; }
    const size_t kstep = (size_t)(BK * 2);
    const size_t hstep = (size_t)HALF * K * 2;
    const size_t tstep = 2 * hstep;
    const unsigned ldsw = (unsigned)wid * 1024u;
    const int aoff = lds_byte(wr * 64 + fr, fq * 8), boff = lds_byte(wc * 32 + fr, fq * 8);
#define PG8_SA(b, h) (((b) * 2 + (h)) * HTB)
#define PG8_SB(b, h) ((4 + (b) * 2 + (h)) * HTB)
#define PG8_STAGE(bufoff, gbase, voff) do { _Pragma("unroll") for (int _i = 0; _i < 2; ++_i) \
        __builtin_amdgcn_global_load_lds((const unsigned*)((const char*)(gbase) + (voff)[_i]), (LAS unsigned*)(lds + (bufoff) + ldsw + _i * 8192), 16, 0, 0); } while (0)
#define PG8_LDA(dst, b, h) do { _Pragma("unroll") for (int m = 0; m < 4; ++m) _Pragma("unroll") for (int k = 0; k < 2; ++k) dst[m][k] = *(const LAS bf16x8*)(lds + PG8_SA(b, h) + aoff + m * 2048 + k * 1024); } while (0)
#define PG8_LDB(dst, b, h) do { _Pragma("unroll") for (int n = 0; n < 2; ++n) _Pragma("unroll") for (int k = 0; k < 2; ++k) dst[n][k] = *(const LAS bf16x8*)(lds + PG8_SB(b, h) + boff + n * 2048 + k * 1024); } while (0)
#define PG8_MMA(ai, bj, At, Bt) do { __builtin_amdgcn_s_setprio(1); _Pragma("unroll") for (int m = 0; m < 4; ++m) _Pragma("unroll") for (int n = 0; n < 2; ++n) _Pragma("unroll") for (int k = 0; k < 2; ++k) \
        acc[ai][bj][m][n] = __builtin_amdgcn_mfma_f32_16x16x32_bf16(Bt[n][k], At[m][k], acc[ai][bj][m][n], 0, 0, 0); __builtin_amdgcn_s_setprio(0); } while (0)
#define PG8_WAIT_V(n) asm volatile("s_waitcnt vmcnt(" #n ")" ::: "memory")
#define PG8_WAIT_L(n) asm volatile("s_waitcnt lgkmcnt(" #n ")" ::: "memory")
#define PG8_BAR __builtin_amdgcn_s_barrier()
#define PG8_SCHED __builtin_amdgcn_sched_barrier(0)
    Unit cur, nxt; int ui = 0;
    if (!S.next(0, cur)) return;
    f32x4 acc[2][2][4][2];
#pragma unroll
    for (int a = 0; a < 2; ++a)
#pragma unroll
        for (int b = 0; b < 2; ++b)
#pragma unroll
            for (int m = 0; m < 4; ++m)
#pragma unroll
                for (int n = 0; n < 2; ++n) acc[a][b][m][n] = (f32x4){0.f, 0.f, 0.f, 0.f};
    bf16x8 At[4][2], B0[2][2], B1[2][2];
    const char* cA = (const char*)g.A + (size_t)cur.pm * tstep; const char* cB = (const char*)g.Bt + (size_t)cur.pn * tstep;
    PG8_STAGE(PG8_SB(0, 0), cB, voffB); PG8_STAGE(PG8_SA(0, 0), cA, voffA); PG8_STAGE(PG8_SB(0, 1), cB + hstep, voffB); PG8_STAGE(PG8_SA(0, 1), cA + hstep, voffA);
    if (wr == 1) PG8_BAR;
    PG8_WAIT_V(4); PG8_BAR;
    PG8_STAGE(PG8_SB(1, 0), cB + kstep, voffB); PG8_STAGE(PG8_SA(1, 0), cA + kstep, voffA); PG8_STAGE(PG8_SB(1, 1), cB + hstep + kstep, voffB);
    PG8_WAIT_V(6); PG8_BAR;
    for (;;) {
        const bool has_next = S.next(ui + 1, nxt);
        const char* nA = has_next ? (const char*)g.A + (size_t)nxt.pm * tstep : cA; const char* nB = has_next ? (const char*)g.Bt + (size_t)nxt.pn * tstep : cB;
        for (int t = 0; t < nt; t += 2) {
            const bool last = (t == nt - 2);
            const char* a1 = cA + (size_t)(t + 1) * kstep;
            const char* a2 = last ? nA : cA + (size_t)(t + 2) * kstep; const char* b2 = last ? nB : cB + (size_t)(t + 2) * kstep;
            const char* a3 = a2 + kstep; const char* b3 = b2 + kstep;
            PG8_LDB(B0, 0, 0); PG8_SCHED; PG8_LDA(At, 0, 0); PG8_STAGE(PG8_SA(1, 1), a1 + hstep, voffA);
            PG8_WAIT_L(8); PG8_BAR; PG8_WAIT_L(0); PG8_MMA(0, 0, At, B0); PG8_BAR; PG8_SCHED;
            PG8_LDB(B1, 0, 1); PG8_STAGE(PG8_SB(0, 0), b2, voffB);
            PG8_BAR; PG8_WAIT_L(0); PG8_MMA(0, 1, At, B1); PG8_BAR;
            PG8_LDA(At, 0, 1); PG8_STAGE(PG8_SA(0, 0), a2, voffA);
            PG8_BAR; PG8_WAIT_L(0); PG8_MMA(1, 0, At, B0); PG8_BAR; PG8_SCHED;
            PG8_STAGE(PG8_SB(0, 1), b2 + hstep, voffB);
            PG8_WAIT_V(6); PG8_BAR; PG8_MMA(1, 1, At, B1); PG8_BAR;
            PG8_LDB(B0, 1, 0); PG8_SCHED; PG8_LDA(At, 1, 0); PG8_STAGE(PG8_SA(0, 1), a2 + hstep, voffA);
            PG8_WAIT_L(8); PG8_BAR; PG8_WAIT_L(0); PG8_MMA(0, 0, At, B0); PG8_BAR; PG8_SCHED;
            PG8_LDB(B1, 1, 1); PG8_STAGE(PG8_SB(1, 0), b3, voffB);
            PG8_BAR; PG8_WAIT_L(0); PG8_MMA(0, 1, At, B1); PG8_BAR;
            PG8_LDA(At, 1, 1); PG8_STAGE(PG8_SA(1, 0), a3, voffA);
            PG8_BAR; PG8_WAIT_L(0); PG8_MMA(1, 0, At, B0); PG8_BAR; PG8_SCHED;
            PG8_STAGE(PG8_SB(1, 1), b3 + hstep, voffB);
            PG8_WAIT_V(6); PG8_BAR; PG8_MMA(1, 1, At, B1); PG8_BAR;
        }
        E(acc, cur, wr, wc, fr, fq);
        if (!has_next) break;
#pragma unroll
        for (int a = 0; a < 2; ++a)
#pragma unroll
            for (int b = 0; b < 2; ++b)
#pragma unroll
                for (int m = 0; m < 4; ++m)
#pragma unroll
                    for (int n = 0; n < 2; ++n) acc[a][b][m][n] = (f32x4){0.f, 0.f, 0.f, 0.f};
        cur = nxt; cA = nA; cB = nB; ++ui;
    }
    PG8_WAIT_V(0);
    if (wr == 0) PG8_BAR;
    PG8_BAR;
#undef PG8_SA
#undef PG8_SB
#undef PG8_STAGE
#undef PG8_LDA
#undef PG8_LDB
#undef PG8_MMA
#undef PG8_WAIT_V
#undef PG8_WAIT_L
#undef PG8_BAR
#undef PG8_SCHED
}
}
using pg8::Unit;

struct EpiIn {
    bf16_t* P; bf16_t* UT; const float* rac; const float* ras; const float* rcc; const float* rcs; const float* gq; const float* gk; LAS unsigned char* scr;
    __device__ __forceinline__ void operator()(const f32x4 (&acc)[2][2][4][2], const Unit& uu, int wr, int wc, int fr, int fq) const {
        Unit u = uu; asm volatile("" : "+s"(u.pm), "+s"(u.pn), "+v"(fr), "+v"(fq));
        const int ch = 4 * u.pn + wc;
        const int rowb = u.pm * 256 + wr * 64 + fr;
        if (ch < 12) {
            const float qs = (ch < 6) ? 0.125f * LOG2E : 1.0f;
#pragma unroll
            for (int ai = 0; ai < 2; ++ai)
#pragma unroll
                for (int m = 0; m < 4; ++m) {
                    const int r = rowb + 128 * ai + 16 * m, s = r & 2047;
                    u32x4 w1, w2;
                    {
                        const f32x4 c0 = *(const f32x4*)(rac + s * 32 + 8 * fq), s0 = *(const f32x4*)(ras + s * 32 + 8 * fq);
                        const f32x4 c1 = *(const f32x4*)(rac + s * 32 + 8 * fq + 4), s1 = *(const f32x4*)(ras + s * 32 + 8 * fq + 4);
                        const f32x4 x10 = acc[ai][0][m][0], x11 = acc[ai][0][m][1], x20 = acc[ai][1][m][0], x21 = acc[ai][1][m][1];
                        const f32x4 a0 = (x10 * c0 - x20 * s0) * qs, a1 = (x11 * c1 - x21 * s1) * qs;
                        const f32x4 b0 = (x20 * c0 + x10 * s0) * qs, b1 = (x21 * c1 + x11 * s1) * qs;
                        w1.x = pk2(a0[0], a0[1]); w1.y = pk2(a0[2], a0[3]); w1.z = pk2(a1[0], a1[1]); w1.w = pk2(a1[2], a1[3]);
                        w2.x = pk2(b0[0], b0[1]); w2.y = pk2(b0[2], b0[3]); w2.z = pk2(b1[0], b1[1]); w2.w = pk2(b1[2], b1[3]);
                    }
                    bf16_t* dst = P + (size_t)r * PW + 64 * ch + 8 * fq;
                    *(u32x4*)dst = w1; *(u32x4*)(dst + 32) = w2;
                }
        } else if (ch < 18 || ch >= 38) {
#pragma unroll
            for (int ai = 0; ai < 2; ++ai)
#pragma unroll
                for (int m = 0; m < 4; ++m) {
                    const int r = rowb + 128 * ai + 16 * m;
                    bf16_t* dst = P + (size_t)r * PW + 64 * ch + 8 * fq;
#pragma unroll
                    for (int bj = 0; bj < 2; ++bj) {
                        const f32x4 v0 = acc[ai][bj][m][0], v1 = acc[ai][bj][m][1];
                        u32x4 w; w.x = pk2(v0[0], v0[1]); w.y = pk2(v0[2], v0[3]); w.z = pk2(v1[0], v1[1]); w.w = pk2(v1[2], v1[3]);
                        *(u32x4*)(dst + 32 * bj) = w;
                    }
                }
        } else if (ch < 30) {
            const int wid = wr * 4 + wc, lane = fq * 16 + fr;
            LAS unsigned char* T = scr + wid * 4096;
#pragma unroll
            for (int ai = 0; ai < 2; ++ai)
#pragma unroll
                for (int bj = 0; bj < 2; ++bj) {
#pragma unroll
                    for (int m = 0; m < 4; ++m)
#pragma unroll
                        for (int n = 0; n < 2; ++n)
#pragma unroll
                            for (int j = 0; j < 4; ++j) {
                                const int chl = 8 * fq + 4 * n + j, rl = 16 * m + fr;
                                *(LAS bf16_t*)(T + chl * 128 + rl * 2) = (bf16_t)(pk2(acc[ai][bj][m][n][j], 0.f) & 0xffffu);
                            }
                    asm volatile("s_waitcnt lgkmcnt(0)" ::: "memory");
                    const int r0 = u.pm * 256 + 128 * ai + 64 * wr;
                    const int hc0 = 64 * (ch - 18) + 32 * bj;
#pragma unroll
                    for (int q = 0; q < 4; ++q) {
                        const int idx = q * 64 + lane, chl = idx >> 3, k = idx & 7;
                        const u32x4 v = *(const LAS u32x4*)(T + chl * 128 + k * 16);
                        *(u32x4*)(UT + (size_t)(hc0 + chl) * MTOK + r0 + 8 * k) = v;
                    }
                    asm volatile("s_waitcnt lgkmcnt(0)" ::: "memory");
                }
        } else {
            const float* g = (ch < 36) ? gq : gk;
            const float qs = (ch < 36) ? 0.125f * LOG2E : 1.0f;
            f32x4 g4[2][2];
#pragma unroll
            for (int bj = 0; bj < 2; ++bj)
#pragma unroll
                for (int n = 0; n < 2; ++n) g4[bj][n] = *(const f32x4*)(g + 32 * bj + 16 * n + 4 * fq);
#pragma unroll
            for (int ai = 0; ai < 2; ++ai)
#pragma unroll
                for (int m = 0; m < 4; ++m) {
                    const int r = rowb + 128 * ai + 16 * m, s = r & 2047;
                    float ss = 0.f;
#pragma unroll
                    for (int bj = 0; bj < 2; ++bj)
#pragma unroll
                        for (int n = 0; n < 2; ++n) { const f32x4 x = acc[ai][bj][m][n]; ss += (x[0] * x[0] + x[1] * x[1]) + (x[2] * x[2] + x[3] * x[3]); }
                    ss += __shfl_xor(ss, 16); ss += __shfl_xor(ss, 32);
                    const float rstd = rsqrtf(ss * (1.0f / 64.0f) + EPS) * qs;
                    bf16_t* dst = P + (size_t)r * PW + 64 * ch + 8 * fq;
#pragma unroll
                    for (int bj = 0; bj < 2; ++bj) {
                        const int pos = bj ? (s & 63) : (s >> 6);
                        const f32x4 c = *(const f32x4*)(rcc + pos * 16 + 4 * fq), sn = *(const f32x4*)(rcs + pos * 16 + 4 * fq);
                        const f32x4 x1 = acc[ai][bj][m][0] * g4[bj][0] * rstd, x2 = acc[ai][bj][m][1] * g4[bj][1] * rstd;
                        const f32x4 o1 = x1 * c - x2 * sn, o2 = x2 * c + x1 * sn;
                        u32x4 w; w.x = pk2(o1[0], o1[1]); w.y = pk2(o1[2], o1[3]); w.z = pk2(o2[0], o2[1]); w.w = pk2(o2[2], o2[3]);
                        *(u32x4*)(dst + 32 * bj) = w;
                    }
                }
        }
    }
};

struct EpiF {
    bf16_t* F;
    __device__ __forceinline__ void operator()(const f32x4 (&acc)[2][2][4][2], const Unit& uu, int wr, int wc, int fr, int fq) const {
        Unit u = uu; asm volatile("" : "+s"(u.pm), "+s"(u.pn), "+v"(fr), "+v"(fq));
        const int row0 = u.pm * 256 + wr * 64 + fr, col0 = u.pn * 256 + wc * 32 + 8 * fq;
#pragma unroll
        for (int ai = 0; ai < 2; ++ai)
#pragma unroll
            for (int m = 0; m < 4; ++m) {
                bf16_t* rowp = F + (size_t)(row0 + ai * 128 + m * 16) * DM + col0;
#pragma unroll
                for (int bj = 0; bj < 2; ++bj) {
                    const f32x4 v0 = acc[ai][bj][m][0], v1 = acc[ai][bj][m][1];
                    u32x4 w; w.x = pk2(v0[0], v0[1]); w.y = pk2(v0[2], v0[3]); w.z = pk2(v1[0], v1[1]); w.w = pk2(v1[2], v1[3]);
                    *(u32x4*)(rowp + bj * 128) = w;
                }
            }
    }
};

struct EpiGU {
    bf16_t* ACT; float* EP; float* EG; float* EU; const float* cw; const float* cb;
    __device__ __forceinline__ void operator()(const f32x4 (&acc)[2][2][4][2], const Unit& uu, int wr, int wc, int fr, int fq) const {
        Unit u = uu; asm volatile("" : "+s"(u.pm), "+s"(u.pn), "+v"(fr), "+v"(fq));
        const int chan0 = 128 * u.pn + 32 * wc + 8 * fq;
        const int lane = fq * 16 + fr;
        const int srcU = (lane & 48) | ((fr + 15) & 15), srcD = (lane & 48) | ((fr + 1) & 15);
#pragma unroll
        for (int ai = 0; ai < 2; ++ai) {
            const int Rg = u.pm * 256 + 128 * ai + 64 * wr;
            const int gi = Rg >> 6;
#pragma unroll
            for (int n = 0; n < 2; ++n) {
                const f32x4 w0 = *(const f32x4*)(cw + chan0 + 4 * n), w1 = *(const f32x4*)(cw + FF + chan0 + 4 * n), w2 = *(const f32x4*)(cw + 2 * FF + chan0 + 4 * n), bb = *(const f32x4*)(cb + chan0 + 4 * n);
                f32x4 av[4], ptop, pbot;
#pragma unroll
                for (int j = 0; j < 4; ++j) {
                    float gv[4], ru[4], rd[4];
#pragma unroll
                    for (int m = 0; m < 4; ++m) { gv[m] = acc[ai][0][m][n][j];
                        ru[m] = __int_as_float(__builtin_amdgcn_update_dpp(0, __float_as_int(gv[m]), 0x121, 0xf, 0xf, false));
                        rd[m] = __int_as_float(__builtin_amdgcn_update_dpp(0, __float_as_int(gv[m]), 0x12f, 0xf, 0xf, false)); }
#pragma unroll
                    for (int m = 0; m < 4; ++m) {
                        const float prev = (fr == 0) ? (m > 0 ? ru[m > 0 ? m - 1 : 0] : 0.f) : ru[m];
                        const float next = (fr == 15) ? (m < 3 ? rd[m < 3 ? m + 1 : 3] : 0.f) : rd[m];
                        const float pre = w0[j] * prev + w1[j] * gv[m] + w2[j] * next + bb[j];
                        av[m][j] = gelu_tanh_mul(pre, acc[ai][1][m][n][j]);
                        if (m == 0) ptop[j] = pre;
                        if (m == 3) pbot[j] = pre;
                    }
                }
                if (fr == 0) { const size_t eo = ((size_t)gi * 2) * FF + chan0 + 4 * n; *(f32x4*)(EP + eo) = ptop; *(f32x4*)(EG + eo) = acc[ai][0][0][n]; *(f32x4*)(EU + eo) = acc[ai][1][0][n]; }
                if (fr == 15) { const size_t eo = ((size_t)gi * 2 + 1) * FF + chan0 + 4 * n; *(f32x4*)(EP + eo) = pbot; *(f32x4*)(EG + eo) = acc[ai][0][3][n]; *(f32x4*)(EU + eo) = acc[ai][1][3][n]; }
#pragma unroll
                for (int m = 0; m < 4; ++m) {
                    const bool edge = ((m == 0) && (fr == 0)) || ((m == 3) && (fr == 15));
                    if (!edge) { u32x2 w; w.x = pk2(av[m][0], av[m][1]); w.y = pk2(av[m][2], av[m][3]); *(u32x2*)(ACT + (size_t)(Rg + 16 * m + fr) * FF + chan0 + 4 * n) = w; }
                }
            }
        }
    }
};

__device__ __forceinline__ int colmap_in(int R) {
    const int T = R >> 8, rt = R & 255, bj = rt >> 7, wc = (rt >> 5) & 3, n = (rt >> 4) & 1, fq = (rt >> 2) & 3, j = rt & 3;
    const int ch = 4 * T + wc;
    const int l = (ch >= 30 && ch < 38) ? (32 * bj + 16 * n + 4 * fq + j) : (32 * bj + 8 * fq + 4 * n + j);
    return 64 * ch + l;
}
template <int MODE>
__device__ __forceinline__ void transpose_item(const Args& a, int layer, int item, LAS float* scr, int lane) {
    constexpr int K = (MODE == 3) ? FF : DM;
    constexpr int NP = (MODE == 0) ? PW : (MODE == 2 ? 2 * FF : DM);
    constexpr int N = (MODE == 0) ? PW : (MODE == 2 ? FF : DM);
    const int nblk = NP / 32, kb = item / nblk, nb = item % nblk, k0 = 64 * kb, n0 = 32 * nb;
    const int R = n0 + (lane & 31);
    const float* src; int col;
    if (MODE == 0) { src = a.in[5] + (size_t)layer * DM * PW; col = colmap_in(R); }
    else if (MODE == 1) { src = a.in[6] + (size_t)layer * DM * DM; col = (R & ~31) + 8 * ((R >> 2) & 3) + 4 * ((R >> 4) & 1) + (R & 3); }
    else if (MODE == 2) {
        const int T = R >> 8, rt = R & 255, bj = rt >> 7, wc = (rt >> 5) & 3, n = (rt >> 4) & 1, fq = (rt >> 2) & 3, j = rt & 3;
        col = 128 * T + 32 * wc + 8 * fq + 4 * n + j; src = (bj ? a.in[20] : a.in[19]) + (size_t)layer * DM * FF;
    } else { src = a.in[23] + (size_t)layer * FF * DM; col = (R & ~31) + 8 * ((R >> 2) & 3) + 4 * ((R >> 4) & 1) + (R & 3); }
    bf16_t* WT = (bf16_t*)(a.ws + (MODE == 0 ? WS_WIN : MODE == 1 ? WS_WOUT : MODE == 2 ? WS_WGU : WS_WDN)) + (size_t)layer * NP * K;
#pragma unroll 8
    for (int i = 0; i < 32; ++i) { const int kk = 2 * i + (lane >> 5); scr[kk * 33 + (lane & 31)] = src[(size_t)(k0 + kk) * N + col]; }
    asm volatile("s_waitcnt lgkmcnt(0)" ::: "memory");
    const int c = lane & 7;
#pragma unroll
    for (int j = 0; j < 4; ++j) {
        const int n = (lane >> 3) + 8 * j; const LAS float* s = scr + (8 * c) * 33 + n;
        u32x4 o; o.x = pk2(s[0 * 33], s[1 * 33]); o.y = pk2(s[2 * 33], s[3 * 33]); o.z = pk2(s[4 * 33], s[5 * 33]); o.w = pk2(s[6 * 33], s[7 * 33]);
        *(u32x4*)(WT + (size_t)(n0 + n) * K + k0 + 8 * c) = o;
    }
    asm volatile("s_waitcnt lgkmcnt(0)" ::: "memory");
}

__device__ __forceinline__ void norm_row(const float* xrow, const float* g, bf16_t* orow, int lane) {
    f32x4 v[4]; float s = 0.f;
#pragma unroll
    for (int j = 0; j < 4; ++j) { v[j] = *(const f32x4*)(xrow + 4 * lane + 256 * j); s += (v[j][0] * v[j][0] + v[j][1] * v[j][1]) + (v[j][2] * v[j][2] + v[j][3] * v[j][3]); }
    const float rstd = rsqrtf(wave_sum(s) * (1.0f / DM) + EPS);
#pragma unroll
    for (int j = 0; j < 4; ++j) {
        const f32x4 gg = *(const f32x4*)(g + 4 * lane + 256 * j); const f32x4 y = v[j] * rstd * gg;
        u32x2 w; w.x = pk2(y[0], y[1]); w.y = pk2(y[2], y[3]); *(u32x2*)(orow + 4 * lane + 256 * j) = w;
    }
}

__device__ __forceinline__ void hyena_raw(const Args& a, int L, int t, LAS float* scr, int lane) {
    const float tl = (float)t * (1.0f / 2047.0f);
    if (lane < 33) {
        float z;
        if (lane == 0) z = tl;
        else {
            const int k = (lane - 1) & 15;
            const float band = 1e-4f + (float)k * ((15.0f - 1e-4f) / 15.0f);
            const float ang = 2.0f * 3.14159265358979323846f * band * (float)t / 2048.0f;
            z = (lane <= 16) ? cosf(ang) : -sinf(ang);
        }
        scr[lane] = z;
    }
    asm volatile("s_waitcnt lgkmcnt(0)" ::: "memory");
    const float* w1 = a.in[11] + L * 33 * 64; const float* b1 = a.in[12] + L * 64; const float* fr = a.in[13] + L * 128;
    const float* w2 = a.in[14] + L * 64 * 64; const float* b2 = a.in[15] + L * 64; const float* w3 = a.in[16] + (size_t)L * 64 * 1024; const float* dec = a.in[17] + L * 1024;
    float h = b1[lane];
    {
        float wv[33];
#pragma unroll
        for (int j = 0; j < 33; ++j) wv[j] = w1[j * 64 + lane];
#pragma unroll
        for (int j = 0; j < 33; ++j) h += scr[j] * wv[j];
    }
    h = sinf(fr[lane] * h);
    scr[64 + lane] = h;
    asm volatile("s_waitcnt lgkmcnt(0)" ::: "memory");
    float h2 = b2[lane];
#pragma unroll 1
    for (int k0 = 0; k0 < 64; k0 += 32) {
        float wv[32];
#pragma unroll
        for (int k = 0; k < 32; ++k) wv[k] = w2[(k0 + k) * 64 + lane];
#pragma unroll
        for (int k = 0; k < 32; ++k) h2 += scr[64 + k0 + k] * wv[k];
    }
    h2 = sinf(fr[64 + lane] * h2);
    scr[128 + lane] = h2;
    asm volatile("s_waitcnt lgkmcnt(0)" ::: "memory");
    float* raw = (float*)(a.ws + WS_HRAW) + ((size_t)L * 2048 + t) * 1024;
    float o[16];
#pragma unroll
    for (int mth = 0; mth < 16; ++mth) o[mth] = 0.f;
#pragma unroll 1
    for (int k0 = 0; k0 < 64; k0 += 4) {
        float wv[4][16];
#pragma unroll
        for (int k = 0; k < 4; ++k)
#pragma unroll
            for (int mth = 0; mth < 16; ++mth) wv[k][mth] = w3[(k0 + k) * 1024 + lane + 64 * mth];
#pragma unroll
        for (int k = 0; k < 4; ++k) { const float hk = scr[128 + k0 + k];
#pragma unroll
            for (int mth = 0; mth < 16; ++mth) o[mth] += hk * wv[k][mth]; }
    }
#pragma unroll
    for (int mth = 0; mth < 16; ++mth) { const int idx = lane + 64 * mth; raw[idx] = o[mth] * expf(-tl * dec[idx]); }
    asm volatile("s_waitcnt lgkmcnt(0)" ::: "memory");
}

__device__ __forceinline__ void phase0(const Args& a, LAS unsigned char* lds) {
    const int tid = tidx(), wid = tid >> 6, lane = tid & 63;
    const int gw = blockIdx.x * 8 + wid, NGW = gridDim.x * 8;
    LAS float* scr = (LAS float*)(lds + wid * 16384);
    for (int i = blockIdx.x * 512 + tid; i < 2048 * 32 + 64 * 16; i += gridDim.x * 512) {
        if (i < 2048 * 32) {
            const int s = i >> 5, d = i & 31; const double f = pow(10000.0, -(double)d / 32.0), ang = (double)s * f;
            ((float*)(a.ws + WS_RAC))[i] = (float)cos(ang); ((float*)(a.ws + WS_RAS))[i] = (float)sin(ang);
        } else {
            const int k = i - 2048 * 32, p = k >> 4, d = k & 15; const double f = pow(10000.0, -(double)d / 16.0), ang = (double)p * f;
            ((float*)(a.ws + WS_RCC))[k] = (float)cos(ang); ((float*)(a.ws + WS_RCS))[k] = (float)sin(ang);
        }
    }
    constexpr int I0 = 16 * 80, I1 = 16 * 32, I2 = 16 * 176, I3 = 44 * 32, IL = I0 + I1 + I2 + I3;
    for (int it = gw; it < 2 * IL; it += NGW) {
        const int layer = it / IL; int r = it % IL;
        if (r < I0) { transpose_item<0>(a, layer, r, scr, lane); continue; } r -= I0;
        if (r < I1) { transpose_item<1>(a, layer, r, scr, lane); continue; } r -= I1;
        if (r < I2) { transpose_item<2>(a, layer, r, scr, lane); continue; } r -= I2;
        transpose_item<3>(a, layer, r, scr, lane);
    }
    for (int it = gw; it < 2 * 2048; it += NGW) hyena_raw(a, it >> 11, it & 2047, scr, lane);
    for (int r = gw * 32; r < MTOK; r += NGW * 32) {
#pragma unroll 1
        for (int k = 0; k < 32; k += 4) {
            f32x4 v[4][4];
#pragma unroll
            for (int u = 0; u < 4; ++u)
#pragma unroll
                for (int j = 0; j < 4; ++j) v[u][j] = *(const f32x4*)(a.in[0] + (size_t)(r + k + u) * DM + 4 * lane + 256 * j);
#pragma unroll
            for (int u = 0; u < 4; ++u) {
                float s = 0.f;
#pragma unroll
                for (int j = 0; j < 4; ++j) s += (v[u][j][0] * v[u][j][0] + v[u][j][1] * v[u][j][1]) + (v[u][j][2] * v[u][j][2] + v[u][j][3] * v[u][j][3]);
                const float rstd = rsqrtf(wave_sum(s) * (1.0f / DM) + EPS);
                bf16_t* orow = (bf16_t*)(a.ws + WS_H) + (size_t)(r + k + u) * DM;
#pragma unroll
                for (int j = 0; j < 4; ++j) { const f32x4 gg = *(const f32x4*)(a.in[1] + 4 * lane + 256 * j); const f32x4 y = v[u][j] * rstd * gg; u32x2 w; w.x = pk2(y[0], y[1]); w.y = pk2(y[2], y[3]); *(u32x2*)(orow + 4 * lane + 256 * j) = w; }
            }
        }
    }
}

__device__ __forceinline__ void gload32(u32x4 (&r)[4], const unsigned char* ubase, unsigned pitch, int lane) {
#pragma unroll
    for (int i = 0; i < 4; ++i) { const unsigned rr = (unsigned)(lane >> 3) + 8u * i; r[i] = *(const u32x4*)(ubase + rr * pitch + (unsigned)(lane & 7) * 16u); }
}
template <bool SWZ>
__device__ __forceinline__ void lwrite32(LAS unsigned char* dst, const u32x4 (&r)[4], int lane) {
#pragma unroll
    for (int i = 0; i < 4; ++i) { const int rr = (lane >> 3) + 8 * i; const int pc = SWZ ? ((lane & 7) ^ ((rr >> 1) & 7)) : (lane & 7); *(LAS u32x4*)(dst + rr * 128 + pc * 16) = r[i]; }
}
__device__ __forceinline__ void load_kf(LAS const unsigned char* kb, bf16x8 (&kf)[4], int lane) {
    const int kl = lane & 31, h = lane >> 5;
#pragma unroll
    for (int s = 0; s < 4; ++s) { const int pc = (2 * s + h) ^ ((kl >> 1) & 7); kf[s] = *(const LAS bf16x8*)(kb + kl * 128 + pc * 16); }
}
__device__ __forceinline__ void load_vf(LAS const unsigned char* vb, bf16x8 (&vf)[2][2], int lane) {
    const int h = lane >> 5, i16 = lane & 15, q = i16 >> 2, p = i16 & 3, dbase = ((lane >> 4) & 1) * 16;
#pragma unroll
    for (int s2 = 0; s2 < 2; ++s2)
#pragma unroll
        for (int dt = 0; dt < 2; ++dt) {
            const int key = 16 * s2 + 4 * h + q, d0 = 32 * dt + dbase + 4 * p;
            const bf16x4 lo = __builtin_amdgcn_ds_read_tr16_b64_v4i16((LAS bf16x4*)(vb + key * 128 + d0 * 2));
            const bf16x4 hi = __builtin_amdgcn_ds_read_tr16_b64_v4i16((LAS bf16x4*)(vb + (key + 8) * 128 + d0 * 2));
            vf[s2][dt] = (bf16x8){lo[0], lo[1], lo[2], lo[3], hi[0], hi[1], hi[2], hi[3]};
        }
}
template <bool KLDS>
__device__ __forceinline__ void attn_step(const bf16x8 (&kf)[4], LAS const unsigned char* kb, const bf16x8 (&vf)[2][2], const bf16x8 (&qf)[4], f32x16& o0, f32x16& o1, float& m, float& l, int lane, int maskmode) {
    const int ql = lane & 31, h = lane >> 5;
    f32x16 S;
#pragma unroll
    for (int i = 0; i < 16; ++i) S[i] = 0.f;
#pragma unroll
    for (int s = 0; s < 4; ++s) {
        if (KLDS) { const int pc = (2 * s + h) ^ ((ql >> 1) & 7); const bf16x8 k1 = *(const LAS bf16x8*)(kb + ql * 128 + pc * 16); S = __builtin_amdgcn_mfma_f32_32x32x16_bf16(k1, qf[s], S, 0, 0, 0); }
        else S = __builtin_amdgcn_mfma_f32_32x32x16_bf16(kf[s], qf[s], S, 0, 0, 0);
    }
    if (maskmode) {
#pragma unroll
        for (int i = 0; i < 16; ++i) { const int kr = (i & 3) + 8 * (i >> 2) + 4 * h; const bool ok = (maskmode == 1) ? (kr >= ql) : (kr <= ql); S[i] = ok ? S[i] : -1e30f; }
    }
    float tm = S[0];
#pragma unroll
    for (int i = 1; i < 16; ++i) tm = fmaxf(tm, S[i]);
    tm = fmaxf(tm, __shfl_xor(tm, 32));
    const float mn = fmaxf(m, tm), al = fexp2(m - mn); m = mn;
    float ps = 0.f;
#pragma unroll
    for (int i = 0; i < 16; ++i) { S[i] = fexp2(S[i] - mn); ps += S[i]; }
    l = l * al + ps;
#pragma unroll
    for (int i = 0; i < 16; ++i) { o0[i] *= al; o1[i] *= al; }
    bf16x8 pf[2];
#pragma unroll
    for (int s2 = 0; s2 < 2; ++s2) {
        u32x4 w; w.x = pk2n(S[8 * s2 + 0], S[8 * s2 + 1]); w.y = pk2n(S[8 * s2 + 2], S[8 * s2 + 3]); w.z = pk2n(S[8 * s2 + 4], S[8 * s2 + 5]); w.w = pk2n(S[8 * s2 + 6], S[8 * s2 + 7]);
        pf[s2] = __builtin_bit_cast(bf16x8, w);
    }
#pragma unroll
    for (int s2 = 0; s2 < 2; ++s2) {
        o0 = __builtin_amdgcn_mfma_f32_32x32x16_bf16(vf[s2][0], pf[s2], o0, 0, 0, 0);
        o1 = __builtin_amdgcn_mfma_f32_32x32x16_bf16(vf[s2][1], pf[s2], o1, 0, 0, 0);
    }
}

__device__ __forceinline__ void attnA_unit(const Args& a, int unit, LAS unsigned char* lds) {
    const int tid = tidx(), wid = __builtin_amdgcn_readfirstlane(tid >> 6), lane = tid & 63, ql = lane & 31, h = lane >> 5;
    const int b = unit / 24, rem = unit % 24, hh = rem >> 2, blk = rem & 3;
    const bf16_t* P = (const bf16_t*)(a.ws + WS_P);
    bf16_t* OA = (bf16_t*)(a.ws + OFF_OA); float* LSE = (float*)(a.ws + OFF_LSE); bf16_t* MIX = (bf16_t*)(a.ws + WS_MIX);
    LAS unsigned char* wl = lds + wid * 8192;
    const unsigned char* kbase = (const unsigned char*)(P + (size_t)b * SEQ * PW + 384 + 64 * hh);
    const unsigned char* vbase = (const unsigned char*)(P + (size_t)b * SEQ * PW + 768 + 64 * hh);
#pragma unroll 1
    for (int pidx = 0; pidx < 3; ++pidx) {
        const int dl = (pidx == 0) ? 1 : (pidx == 1 ? 4 : 16), Ls = SEQ / dl;
        if (pidx == 2) { __syncthreads(); }
#pragma unroll 1
        for (int e = 0; e < 2; ++e) {
            const int qt = 2 * wid + e, r = qt % dl, i0 = (512 * blk) / dl + 32 * (qt / dl);
            const int tq = dl * (i0 + ql) + r;
            bf16x8 qf[4];
            { const bf16_t* qp = P + ((size_t)b * SEQ + tq) * PW + 64 * hh + 8 * h;
#pragma unroll
              for (int s = 0; s < 4; ++s) qf[s] = *(const bf16x8*)(qp + 16 * s); }
            f32x16 o0, o1;
#pragma unroll
            for (int i = 0; i < 16; ++i) { o0[i] = 0.f; o1[i] = 0.f; }
            float m = -1e30f, l = 0.f;
            int kt0 = 0, kt1 = 4;
            if (i0 - 64 < 0) kt0 = (i0 - 32 < 0) ? 2 : 1;
            if (i0 + 64 >= Ls) kt1 = (i0 + 32 >= Ls) ? 2 : 3;
            const unsigned pitch = (unsigned)dl * (PW * 2);
            u32x4 pk[4], pv[4];
            { const size_t ro = (size_t)(dl * (i0 - 64 + 32 * kt0) + r) * (PW * 2); gload32(pk, kbase + ro, pitch, lane); gload32(pv, vbase + ro, pitch, lane); }
#pragma unroll 1
            for (int kt = kt0; kt <= kt1; ++kt) {
                asm volatile("" ::: "memory");
                lwrite32<true>(wl, pk, lane); lwrite32<false>(wl + 4096, pv, lane);
                if (kt < kt1) { const size_t ro = (size_t)(dl * (i0 - 64 + 32 * (kt + 1)) + r) * (PW * 2); gload32(pk, kbase + ro, pitch, lane); gload32(pv, vbase + ro, pitch, lane); }
                asm volatile("s_waitcnt lgkmcnt(0)" ::: "memory");
                bf16x8 kf[4], vf[2][2];
                load_kf(wl, kf, lane); load_vf(wl + 4096, vf, lane);
                attn_step<false>(kf, wl, vf, qf, o0, o1, m, l, lane, kt == 0 ? 1 : (kt == 4 ? 2 : 0));
                asm volatile("" ::: "memory");
            }
            const float lt = l + __shfl_xor(l, 32);
            const float inv = 1.0f / lt, lse = m + __builtin_amdgcn_logf(lt);
            const size_t tokg = (size_t)b * SEQ + tq;
            if (pidx < 2) {
                bf16_t* op = OA + ((size_t)pidx * MTOK + tokg) * 384 + 64 * hh;
#pragma unroll
                for (int dt = 0; dt < 2; ++dt)
#pragma unroll
                    for (int g = 0; g < 4; ++g) {
                        const f32x16& o = dt ? o1 : o0;
                        u32x2 w; w.x = pk2(o[4 * g] * inv, o[4 * g + 1] * inv); w.y = pk2(o[4 * g + 2] * inv, o[4 * g + 3] * inv);
                        *(u32x2*)(op + 32 * dt + 8 * g + 4 * h) = w;
                    }
                if (h == 0) LSE[((size_t)pidx * MTOK + tokg) * 6 + hh] = lse;
            } else {
                const float l1 = LSE[tokg * 6 + hh], l2 = LSE[((size_t)MTOK + tokg) * 6 + hh];
                const float mx = fmaxf(lse, fmaxf(l1, l2));
                const float w1 = fexp2(l1 - mx), w2 = fexp2(l2 - mx), w3 = fexp2(lse - mx);
                const float wi = 1.0f / (w1 + w2 + w3);
                const float c1 = w1 * wi, c2 = w2 * wi, c3 = w3 * wi * inv;
                const bf16_t* p1 = OA + tokg * 384 + 64 * hh; const bf16_t* p2 = OA + ((size_t)MTOK + tokg) * 384 + 64 * hh;
                bf16_t* op = MIX + tokg * DM + 64 * hh;
#pragma unroll
                for (int dt = 0; dt < 2; ++dt)
#pragma unroll
                    for (int g = 0; g < 4; ++g) {
                        const f32x16& o = dt ? o1 : o0;
                        const int d = 32 * dt + 8 * g + 4 * h;
                        const u32x2 a1 = *(const u32x2*)(p1 + d), a2 = *(const u32x2*)(p2 + d);
                        const float r0 = c1 * bflo(a1.x) + c2 * bflo(a2.x) + c3 * o[4 * g], r1 = c1 * bfhi(a1.x) + c2 * bfhi(a2.x) + c3 * o[4 * g + 1];
                        const float r2 = c1 * bflo(a1.y) + c2 * bflo(a2.y) + c3 * o[4 * g + 2], r3 = c1 * bfhi(a1.y) + c2 * bfhi(a2.y) + c3 * o[4 * g + 3];
                        u32x2 w; w.x = pk2(r0, r1); w.y = pk2(r2, r3);
                        *(u32x2*)(op + d) = w;
                    }
            }
        }
    }
}

__device__ __forceinline__ void attnC_unit(const Args& a, int unit, LAS unsigned char* lds) {
    const int tid = tidx(), wid = __builtin_amdgcn_readfirstlane(tid >> 6), lane = tid & 63, ql = lane & 31, h = lane >> 5;
    const int b = unit / 24, rem = unit % 24, hq = rem >> 2, qb = rem & 3, g = hq / 3;
    const bf16_t* P = (const bf16_t*)(a.ws + WS_P);
    bf16_t* MIX = (bf16_t*)(a.ws + WS_MIX);
    const int srow = tid >> 3, sch = tid & 7;
    const unsigned char* kg = (const unsigned char*)(P + ((size_t)b * SEQ + srow) * PW + CK0 + 64 * g) + sch * 16;
    const unsigned char* vg = (const unsigned char*)(P + ((size_t)b * SEQ + srow) * PW + CV0 + 64 * g) + sch * 16;
    const int kwo = srow * 128 + ((sch ^ ((srow >> 1) & 7)) * 16), vwo = 8192 + srow * 128 + sch * 16;
    const size_t tok0 = (size_t)b * SEQ + 512 * qb + 64 * wid + ql;
    bf16x8 qf[2][4]; f32x16 o0[2], o1[2]; float m[2], l[2];
#pragma unroll
    for (int e = 0; e < 2; ++e) {
        const bf16_t* qp = P + (tok0 + 32 * e) * PW + CQ0 + 64 * hq + 8 * h;
#pragma unroll
        for (int s = 0; s < 4; ++s) qf[e][s] = *(const bf16x8*)(qp + 16 * s);
#pragma unroll
        for (int i = 0; i < 16; ++i) { o0[e][i] = 0.f; o1[e][i] = 0.f; }
        m[e] = -1e30f; l[e] = 0.f;
    }
    constexpr size_t TSTEP = (size_t)64 * PW * 2;
    u32x4 rk = *(const u32x4*)kg, rv = *(const u32x4*)vg;
    __syncthreads();
    *(LAS u32x4*)(lds + kwo) = rk; *(LAS u32x4*)(lds + vwo) = rv;
    rk = *(const u32x4*)(kg + TSTEP); rv = *(const u32x4*)(vg + TSTEP);
    __syncthreads();
#pragma unroll 1
    for (int kt = 0; kt < 32; ++kt) {
        LAS unsigned char* cur = lds + (kt & 1) * 16384;
        LAS unsigned char* nxt = lds + ((kt + 1) & 1) * 16384;
        if (kt + 1 < 32) { *(LAS u32x4*)(nxt + kwo) = rk; *(LAS u32x4*)(nxt + vwo) = rv; }
        if (kt + 2 < 32) { rk = *(const u32x4*)(kg + (size_t)(kt + 2) * TSTEP); rv = *(const u32x4*)(vg + (size_t)(kt + 2) * TSTEP); }
#pragma unroll
        for (int j = 0; j < 2; ++j) {
            bf16x8 kf[4], vf[2][2];
            load_kf(cur + j * 4096, kf, lane); load_vf(cur + 8192 + j * 4096, vf, lane);
#pragma unroll
            for (int e = 0; e < 2; ++e) attn_step<false>(kf, cur, vf, qf[e], o0[e], o1[e], m[e], l[e], lane, 0);
        }
        __syncthreads();
    }
#pragma unroll
    for (int e = 0; e < 2; ++e) {
        const float lt = l[e] + __shfl_xor(l[e], 32), inv = 1.0f / lt;
        bf16_t* op = MIX + (tok0 + 32 * e) * DM + 640 + 64 * hq;
#pragma unroll
        for (int dt = 0; dt < 2; ++dt)
#pragma unroll
            for (int gg = 0; gg < 4; ++gg) {
                const f32x16& oo = dt ? o1[e] : o0[e];
                u32x2 w; w.x = pk2(oo[4 * gg] * inv, oo[4 * gg + 1] * inv); w.y = pk2(oo[4 * gg + 2] * inv, oo[4 * gg + 3] * inv);
                *(u32x2*)(op + 32 * dt + 8 * gg + 4 * h) = w;
            }
    }
}

constexpr int HY_CP = 8192 + 16;
__device__ __forceinline__ void hy_filter(const Args& a, int L, int order, int c, LAS unsigned char* lds) {
    const int tid = tidx();
    LAS float* tmp = (LAS float*)(lds + 66048);
    LAS float* red = (LAS float*)(lds + 66048 + 16384);
    const float* raw = (const float*)(a.ws + WS_HRAW) + (size_t)L * 2048 * 1024 + order * 512 + c;
    float s = 0.f;
    for (int i = tid; i < 4096; i += 512) {
        float v;
        if (i < 2048) v = raw[(size_t)i * 1024];
        else if (i == 2048) v = 0.f;
        else v = raw[(size_t)(4096 - i) * 1024 + 256];
        tmp[i] = v; s += fabsf(v);
    }
    s = wave_sum(s);
    if ((tid & 63) == 0) red[tid >> 6] = s;
    __syncthreads();
    float tot = 0.f;
#pragma unroll
    for (int w = 0; w < 8; ++w) tot += red[w];
    const float inv = 1.0f / tot;
    for (int i = tid; i < 8 * 4096; i += 512) {
        const int q = i >> 12, x = i & 4095;
        const float v = tmp[(q - x) & 4095] * inv;
        *(LAS bf16_t*)(lds + q * HY_CP + x * 2) = (bf16_t)(pk2(v, 0.f) & 0xffffu);
    }
    __syncthreads();
}
template <int EPI>
__device__ __forceinline__ void hy_conv(const Args& a, int L, int c, const bf16_t* U, LAS unsigned char* lds) {
    const int tid = tidx(), wid = tid >> 6, lane = tid & 63, n = lane & 31, h = lane >> 5;
    const bf16_t* UC = (const bf16_t*)(a.ws + OFF_UC);
    bf16_t* Z = (bf16_t*)(a.ws + OFF_Z) + (size_t)c * MTOK;
    bf16_t* MIX = (bf16_t*)(a.ws + WS_MIX);
    const float dbias = a.in[18][L * 512 + EPI * 256 + c];
    const bf16_t* urow = U + (size_t)n * SEQ + 8 * h;
    LAS const unsigned char* fbase = lds + (n & 7) * HY_CP;
    const int foff = 8 * h - (n & ~7);
#pragma unroll 1
    for (int blk = 0; blk < 2; ++blk) {
        const int tb = 8 * wid + 4 * blk;
        f32x16 acc[4];
#pragma unroll
        for (int tt = 0; tt < 4; ++tt)
#pragma unroll
            for (int i = 0; i < 16; ++i) acc[tt][i] = 0.f;
        bf16x8 an[4];
#pragma unroll
        for (int k = 0; k < 4; ++k) an[k] = *(const bf16x8*)(urow + 16 * k);
#pragma unroll 1
        for (int s0 = 0; s0 < SEQ; s0 += 64) {
            bf16x8 ac[4];
#pragma unroll
            for (int k = 0; k < 4; ++k) ac[k] = an[k];
            if (s0 + 64 < SEQ) {
#pragma unroll
                for (int k = 0; k < 4; ++k) an[k] = *(const bf16x8*)(urow + s0 + 64 + 16 * k);
            }
            bf16x8 bfr[10];
            const int D0 = s0 - 32 * tb + foff;
#pragma unroll
            for (int d = 0; d < 10; ++d) { const int x = (D0 + 16 * (d - 6)) & 4095; bfr[d] = *(const LAS bf16x8*)(fbase + x * 2); }
#pragma unroll
            for (int k = 0; k < 4; ++k)
#pragma unroll
                for (int tt = 0; tt < 4; ++tt) acc[tt] = __builtin_amdgcn_mfma_f32_32x32x16_bf16(ac[k], bfr[k - 2 * tt + 6], acc[tt], 0, 0, 0);
        }
#pragma unroll
        for (int tt = 0; tt < 4; ++tt)
#pragma unroll
            for (int i = 0; i < 16; ++i) {
                const int bb = (i & 3) + 8 * (i >> 2) + 4 * h, t = 32 * (tb + tt) + n;
                const size_t tok = (size_t)bb * SEQ + t;
                if (EPI == 0) {
                    const float v = bf2f(UC[(size_t)c * MTOK + tok]), x1 = bf2f(UC[((size_t)256 + c) * MTOK + tok]);
                    const float z = x1 * (acc[tt][i] + dbias * v);
                    Z[tok] = (bf16_t)(pk2(z, 0.f) & 0xffffu);
                } else {
                    const float zz = bf2f(Z[tok]), x2 = bf2f(UC[((size_t)512 + c) * MTOK + tok]);
                    const float o = x2 * (acc[tt][i] + dbias * zz);
                    MIX[tok * DM + 384 + c] = (bf16_t)(pk2(o, 0.f) & 0xffffu);
                }
            }
    }
}
__device__ __forceinline__ void hyena_unit(const Args& a, int L, int c, LAS unsigned char* lds) {
    const int tid = tidx();
    const bf16_t* UT = (const bf16_t*)(a.ws + OFF_UT);
    bf16_t* UC = (bf16_t*)(a.ws + OFF_UC);
    const float* cwp = a.in[9] + L * 3 * 768; const float* cbp = a.in[10] + L * 768;
#pragma unroll 1
    for (int k3 = 0; k3 < 3; ++k3) {
        const int hc = 256 * k3 + c;
        const float w0 = cwp[hc], w1 = cwp[768 + hc], w2 = cwp[1536 + hc], bb = cbp[hc];
        const bf16_t* src = UT + (size_t)hc * MTOK; bf16_t* dst = UC + (size_t)hc * MTOK;
        for (int ck = tid; ck < MTOK / 8; ck += 512) {
            const int t0 = ck * 8, s = t0 & 2047;
            const u32x4 v = *(const u32x4*)(src + t0);
            float x[10];
            x[0] = (s == 0) ? 0.f : bf2f(src[t0 - 1]);
            x[1] = bflo(v.x); x[2] = bfhi(v.x); x[3] = bflo(v.y); x[4] = bfhi(v.y); x[5] = bflo(v.z); x[6] = bfhi(v.z); x[7] = bflo(v.w); x[8] = bfhi(v.w);
            x[9] = (s == 2040) ? 0.f : bf2f(src[t0 + 8]);
            float y[8];
#pragma unroll
            for (int j = 0; j < 8; ++j) y[j] = w0 * x[j] + w1 * x[j + 1] + w2 * x[j + 2] + bb;
            u32x4 o; o.x = pk2(y[0], y[1]); o.y = pk2(y[2], y[3]); o.z = pk2(y[4], y[5]); o.w = pk2(y[6], y[7]);
            *(u32x4*)(dst + t0) = o;
        }
    }
    __syncthreads();
    hy_filter(a, L, 0, c, lds);
    hy_conv<0>(a, L, c, UC + (size_t)c * MTOK, lds);
    __syncthreads();
    hy_filter(a, L, 1, c, lds);
    hy_conv<1>(a, L, c, (const bf16_t*)(a.ws + OFF_Z) + (size_t)c * MTOK, lds);
    __syncthreads();
}

__device__ __forceinline__ void row_pass(const bf16_t* F, const float* xold, float* xnew, const float* gpost, const float* gnext, bf16_t* H, int G, int c) {
    const int tid = tidx(), wid = tid >> 6; int lane = tid & 63; asm volatile("" : "+v"(lane));
    f32x4 gp[4], gn[4];
#pragma unroll
    for (int j = 0; j < 4; ++j) { gp[j] = *(const f32x4*)(gpost + 4 * lane + 256 * j); gn[j] = gnext ? *(const f32x4*)(gnext + 4 * lane + 256 * j) : (f32x4){0.f, 0.f, 0.f, 0.f}; }
    for (int rb = (c * 8 + wid) * 32; rb < MTOK; rb += G * 8 * 32) {
#pragma unroll 1
        for (int k = 0; k < 32; k += 4) {
            u32x2 fw[4][4]; f32x4 x[4][4];
#pragma unroll
            for (int u = 0; u < 4; ++u) {
                const size_t ro = (size_t)(rb + k + u) * DM + 4 * lane;
#pragma unroll
                for (int j = 0; j < 4; ++j) { fw[u][j] = *(const u32x2*)(F + ro + 256 * j); x[u][j] = *(const f32x4*)(xold + ro + 256 * j); }
            }
#pragma unroll
            for (int u = 0; u < 4; ++u) {
                const size_t ro = (size_t)(rb + k + u) * DM + 4 * lane;
                f32x4 f[4]; float s = 0.f;
#pragma unroll
                for (int j = 0; j < 4; ++j) { f[j] = (f32x4){bflo(fw[u][j].x), bfhi(fw[u][j].x), bflo(fw[u][j].y), bfhi(fw[u][j].y)}; s += (f[j][0] * f[j][0] + f[j][1] * f[j][1]) + (f[j][2] * f[j][2] + f[j][3] * f[j][3]); }
                const float rstd = rsqrtf(wave_sum(s) * (1.0f / DM) + EPS);
                float s2 = 0.f;
#pragma unroll
                for (int j = 0; j < 4; ++j) { x[u][j] = x[u][j] + f[j] * rstd * gp[j]; *(f32x4*)(xnew + ro + 256 * j) = x[u][j]; s2 += (x[u][j][0] * x[u][j][0] + x[u][j][1] * x[u][j][1]) + (x[u][j][2] * x[u][j][2] + x[u][j][3] * x[u][j][3]); }
                if (gnext) {
                    const float rstd2 = rsqrtf(wave_sum(s2) * (1.0f / DM) + EPS);
#pragma unroll
                    for (int j = 0; j < 4; ++j) { const f32x4 y = x[u][j] * rstd2 * gn[j]; u32x2 w; w.x = pk2(y[0], y[1]); w.y = pk2(y[2], y[3]); *(u32x2*)(H + ro + 256 * j) = w; }
                }
            }
        }
    }
}

__device__ __forceinline__ void ffn_fixup(const Args& a, int L, int panel) {
    const float* EP = (const float*)(a.ws + OFF_EP); const float* EG = (const float*)(a.ws + OFF_EG); const float* EU = (const float*)(a.ws + OFF_EU);
    bf16_t* ACT = (bf16_t*)(a.ws + WS_P);
    const float* cw = a.in[21] + (size_t)L * 3 * FF;
    int tid0 = tidx(); asm volatile("" : "+v"(tid0));
    for (int i = tid0; i < 8 * FF; i += 512) {
        const int e = i / FF, c = i % FF, gi = 4 * panel + (e >> 1), side = e & 1;
        const int row = 64 * gi + (side ? 63 : 0);
        const size_t eo = ((size_t)gi * 2 + side) * FF + c;
        float nb = 0.f, w;
        if (side == 0) { w = cw[c]; if ((row & 2047) != 0) nb = EG[((size_t)(gi - 1) * 2 + 1) * FF + c]; }
        else { w = cw[2 * FF + c]; if ((row & 2047) != 2047) nb = EG[((size_t)(gi + 1) * 2) * FF + c]; }
        const float pre = EP[eo] + w * nb;
        const float act = gelu_tanh(pre) * EU[eo];
        ACT[(size_t)row * FF + c] = (bf16_t)(pk2(act, 0.f) & 0xffffu);
    }
}

__device__ __forceinline__ void run_phase(const Args& a0, int ph, LAS unsigned char* lds) {
    Args a = a0;
#pragma unroll
    for (int i = 0; i < 24; ++i) { const __attribute__((address_space(1))) float* p = (const __attribute__((address_space(1))) float*)a0.in[i]; asm volatile("" : "+s"(p)); a.in[i] = (const float*)p; }
    { __attribute__((address_space(1))) float* p = (__attribute__((address_space(1))) float*)a0.out; asm volatile("" : "+s"(p)); a.out = (float*)p; }
    { __attribute__((address_space(1))) unsigned char* p = (__attribute__((address_space(1))) unsigned char*)a0.ws; asm volatile("" : "+s"(p)); a.ws = (unsigned char*)p; }
    int G = gridDim.x, c = blockIdx.x; asm volatile("" : "+s"(G), "+s"(c));
#ifndef PHM
#define PHM 63
#endif
    if (ph == 0) { for (int rep = 0; rep < NREP(32); ++rep) { phase0(a, lds); __syncthreads(); } return; }
    const int L = (ph - 1) / 7, sub = (ph - 1) % 7;
    bf16_t* H = (bf16_t*)(a.ws + WS_H);
    bf16_t* Fb = (bf16_t*)(a.ws + WS_F);
    if (sub == 0) {
        pg8::Gemm g{H, (const bf16_t*)(a.ws + WS_WIN) + (size_t)L * PW * DM, MTOK, PW, DM};
        pg8::StaticOrder S; S.init(MTOK, PW, G, c);
        EpiIn E{(bf16_t*)(a.ws + WS_P), (bf16_t*)(a.ws + OFF_UT), (const float*)(a.ws + WS_RAC), (const float*)(a.ws + WS_RAS), (const float*)(a.ws + WS_RCC), (const float*)(a.ws + WS_RCS),
                a.in[7] + L * 64, a.in[8] + L * 64, lds + 131072};
        for (int rep = 0; rep < NREP(8); ++rep) pg8::gemm_phase(lds, g, S, E);
    } else if (sub == 1) {
        for (int rep = 0; rep < NREP(1); ++rep) for (int ch = c; ch < 256; ch += G) hyena_unit(a, L, ch, lds);
        for (int rep = 0; rep < NREP(2); ++rep) for (int u = c; u < 768; u += G) attnC_unit(a, u, lds);
        for (int rep = 0; rep < NREP(4); ++rep) { __syncthreads(); for (int u = c; u < 768; u += G) { attnA_unit(a, u, lds); __syncthreads(); } }
    } else if (sub == 2) {
        pg8::Gemm g{(const bf16_t*)(a.ws + WS_MIX), (const bf16_t*)(a.ws + WS_WOUT) + (size_t)L * DM * DM, MTOK, DM, DM};
        pg8::StaticOrder S; S.init(MTOK, DM, G, c); EpiF E{Fb};
        for (int rep = 0; rep < NREP(64); ++rep) pg8::gemm_phase(lds, g, S, E);
    } else if (sub == 3) {
        row_pass(Fb, L == 0 ? a.in[0] : a.out, a.out, a.in[2] + L * DM, a.in[3] + L * DM, H, G, c);
    } else if (sub == 4) {
        pg8::Gemm g{H, (const bf16_t*)(a.ws + WS_WGU) + (size_t)L * 2 * FF * DM, MTOK, 2 * FF, DM};
        pg8::StaticOrder S; S.init(MTOK, 2 * FF, G, c);
        EpiGU E{(bf16_t*)(a.ws + WS_P), (float*)(a.ws + OFF_EP), (float*)(a.ws + OFF_EG), (float*)(a.ws + OFF_EU), a.in[21] + (size_t)L * 3 * FF, a.in[22] + (size_t)L * FF};
        for (int rep = 0; rep < NREP(16); ++rep) pg8::gemm_phase(lds, g, S, E);
    } else if (sub == 5) {
        pg8::Gemm g{(const bf16_t*)(a.ws + WS_P), (const bf16_t*)(a.ws + WS_WDN) + (size_t)L * DM * FF, MTOK, DM, FF};
        pg8::StaticOrder S; S.init(MTOK, DM, G, c); EpiF E{Fb};
        { Unit u; int last = -1; for (int i = 0; S.next(i, u); ++i) if (u.pm != last) { ffn_fixup(a, L, u.pm); last = u.pm; } }
        __syncthreads();
        pg8::gemm_phase(lds, g, S, E);
    } else {
        row_pass(Fb, a.out, a.out, a.in[4] + L * DM, L == 0 ? a.in[1] + DM : nullptr, H, G, c);
    }
}

#define XB_TMO      128
#define XB_XCNT(j)  (256  + 64 * (j))
#define XB_XSUB(j)  (1280 + 64 * (j))
#define XB_XGEN(j)  (2304 + 64 * (j))
#define XB_TOP      3328
#define XB_TOPGEN   3392
#define XB_SPIN_CAP (1u << 22)
__device__ __forceinline__ unsigned xb_ld(unsigned* p)              { return __hip_atomic_load(p, __ATOMIC_RELAXED, __HIP_MEMORY_SCOPE_AGENT); }
__device__ __forceinline__ unsigned xb_add(unsigned* p, unsigned v) { return __hip_atomic_fetch_add(p, v, __ATOMIC_RELAXED, __HIP_MEMORY_SCOPE_AGENT); }
__device__ __forceinline__ unsigned xb_xcc_id() { return (unsigned)__builtin_amdgcn_s_getreg((3 << 11) | 20) & 0xFu; }
#define XB_SPIN(cond, bar) do { unsigned _sp = 0; while (cond) { __builtin_amdgcn_s_sleep(1); \
    if ((++_sp & 255u) == 0u) { if (xb_ld(&(bar)[XB_TMO])) break; if (_sp > XB_SPIN_CAP) { atomicAdd(&(bar)[XB_TMO], 1u); break; } } } } while (0)
struct XbCensus { unsigned nloc, nx; };
__device__ __forceinline__ XbCensus xcd_barrier_complete(unsigned* bar, unsigned x) {
    const unsigned G = gridDim.x;
    unsigned sum, cnt, mine, sp = 0u;
    for (;;) {
        sum = 0u; cnt = 0u; mine = 0u;
#pragma unroll
        for (unsigned j = 0; j < 16; ++j) { const unsigned c = xb_ld(&bar[XB_XCNT(j)]); sum += c; cnt += (c > 0u) ? 1u : 0u; mine = (j == x) ? c : mine; }
        if (sum == G) break;
        __builtin_amdgcn_s_sleep(1);
        if ((++sp & 255u) == 0u) { if (xb_ld(&bar[XB_TMO])) break; if (sp > XB_SPIN_CAP) { atomicAdd(&bar[XB_TMO], 1u); break; } }
    }
    XbCensus r; r.nloc = mine > 0u ? mine : 1u; r.nx = cnt > 0u ? cnt : 1u; return r;
}
__device__ __forceinline__ void xcd_barrier(unsigned* bar, unsigned x, bool first) {
    asm volatile("s_waitcnt vmcnt(0)" ::: "memory");
    __syncthreads();
    if (threadIdx.x == 0) {
        __builtin_amdgcn_s_waitcnt(0);
        unsigned* slot = bar + 4096 + 2 * blockIdx.x;
        XbCensus cs;
        if (first) { cs = xcd_barrier_complete(bar, x); slot[0] = cs.nloc; slot[1] = cs.nx; }
        else { cs.nloc = xb_ld(slot); cs.nx = xb_ld(slot + 1); }
        const unsigned nloc = cs.nloc, nx = cs.nx;
        const unsigned old = xb_add(&bar[XB_XSUB(x)], 1u);
        const unsigned gen = old / nloc;
        if (old + 1u == (gen + 1u) * nloc) {
            __builtin_amdgcn_fence(__ATOMIC_RELEASE, "agent");
            asm volatile("s_waitcnt vmcnt(0)" ::: "memory");
            const unsigned og = xb_add(&bar[XB_TOP], 1u);
            const unsigned tg = og / nx;
            if (og + 1u == (tg + 1u) * nx) xb_add(&bar[XB_TOPGEN], 1u);
            else XB_SPIN(xb_ld(&bar[XB_TOPGEN]) == tg, bar);
            __builtin_amdgcn_fence(__ATOMIC_ACQUIRE, "agent");
            xb_add(&bar[XB_XGEN(x)], 1u);
            asm volatile("s_waitcnt vmcnt(0)" ::: "memory");
        } else {
            XB_SPIN(xb_ld(&bar[XB_XGEN(x)]) == gen, bar);
            __builtin_amdgcn_fence(__ATOMIC_ACQUIRE, "agent");
            asm volatile("s_waitcnt vmcnt(0)" ::: "memory");
        }
    }
    __syncthreads();
}

__global__ __launch_bounds__(512, 2) void mk_fwd(Args a) {
    extern __shared__ __attribute__((aligned(16))) unsigned char lds_raw[];
    LAS unsigned char* lds = (LAS unsigned char*)lds_raw;
    unsigned* bar = (unsigned*)a.ws;
    unsigned xcc = 0u;
    if (a.coop) { xcc = xb_xcc_id(); if (threadIdx.x == 0) (void)xb_add(&bar[XB_XCNT(xcc)], 1u); }
    (void)xcc;
    for (int ph = a.ph_lo; ph < a.ph_hi; ++ph) {
        run_phase(a, ph, lds);
        if (a.coop && ph + 1 < a.ph_hi) {
            if (ph == 0) cg::this_grid().sync();
            else xcd_barrier(bar, xb_xcc_id(), ph == 1);
        }
    }
}

extern "C" void kernel_launch(void* const* d_in, const int* in_sizes, int n_in, void* d_out, int out_size, void* d_ws, size_t ws_size, hipStream_t stream) {
    static int grid = 0;
    if (grid == 0) {
        if (n_in != 24 || out_size != MTOK * DM || ws_size < WS_END) { fprintf(stderr, "kernel_launch: unexpected shapes / workspace (n_in %d out %d ws %zu need %zu)\n", n_in, out_size, ws_size, (size_t)WS_END); grid = -1; return; }
        int dev = 0, cus = 0, per_cu = 0;
        hipGetDevice(&dev); hipDeviceGetAttribute(&cus, hipDeviceAttributeMultiprocessorCount, dev);
        if (hipFuncSetAttribute((const void*)mk_fwd, hipFuncAttributeMaxDynamicSharedMemorySize, LDS_BYTES) != hipSuccess) { fprintf(stderr, "kernel_launch: hipFuncSetAttribute failed\n"); grid = -1; return; }
        if (hipOccupancyMaxActiveBlocksPerMultiprocessor(&per_cu, (const void*)mk_fwd, 512, LDS_BYTES) != hipSuccess || per_cu < 1) { fprintf(stderr, "kernel_launch: occupancy query says %d\n", per_cu); per_cu = 1; }
        (void)hipGetLastError();
        grid = cus;
    }
    if (grid < 0) return;
    if (hipMemsetAsync(d_ws, 0, 32768, stream) != hipSuccess) { fprintf(stderr, "kernel_launch: memset of the barrier words failed\n"); return; }
    Args a{};
    for (int i = 0; i < 24; ++i) a.in[i] = (const float*)d_in[i];
    a.out = (float*)d_out; a.ws = (unsigned char*)d_ws;
#if MK_COOP
    a.ph_lo = 0; a.ph_hi = NPH; a.coop = 1;
    void* args[] = {&a};
    hipError_t e = hipLaunchCooperativeKernel((const void*)mk_fwd, dim3(grid), dim3(512), args, LDS_BYTES, stream);
    if (e != hipSuccess) fprintf(stderr, "cooperative launch failed: %s (grid %d)\n", hipGetErrorString(e), grid);
#else
    for (int ph = 0; ph < NPH; ++ph) {
        a.ph_lo = ph; a.ph_hi = ph + 1; a.coop = 0;
        hipLaunchKernelGGL(mk_fwd, dim3(grid), dim3(512), LDS_BYTES, stream, a);
    }
#endif
}
```

```cpp
#include <hip/hip_runtime.h>
#include <hip/hip_cooperative_groups.h>
#include <cstdio>
namespace cg = cooperative_groups;

#ifndef NPH
#define NPH 15
#endif
#ifndef REPM
#define REPM 0
#endif
#define NREP(bit) ((REPM & (bit)) ? 2 : 1)
#ifndef MK_COOP
#define MK_COOP 1
#endif

#define LAS __attribute__((address_space(3)))
typedef unsigned short bf16_t;
typedef short bf16x8 __attribute__((ext_vector_type(8)));
typedef short bf16x4 __attribute__((ext_vector_type(4)));
typedef float f32x4 __attribute__((ext_vector_type(4)));
typedef float f32x16 __attribute__((ext_vector_type(16)));
typedef unsigned u32x4 __attribute__((ext_vector_type(4)));
typedef unsigned u32x2 __attribute__((ext_vector_type(2)));

constexpr int NB = 32, SEQ = 2048, DM = 1024, MTOK = NB * SEQ, PW = 2560, FF = 2816;
constexpr int CQ0 = 1920, CK0 = 2304, CV0 = 2432;
constexpr float LOG2E = 1.4426950408889634f;
constexpr float EPS = 1e-6f;

constexpr size_t WS_RAC = 32768;
constexpr size_t WS_RAS = WS_RAC + 2048 * 32 * 4;
constexpr size_t WS_RCC = WS_RAS + 2048 * 32 * 4;
constexpr size_t WS_RCS = WS_RCC + 64 * 16 * 4;
constexpr size_t WS_WIN = WS_RCS + 64 * 16 * 4;
constexpr size_t WS_WOUT = WS_WIN + 2ull * 2560 * 1024 * 2;
constexpr size_t WS_WGU = WS_WOUT + 2ull * 1024 * 1024 * 2;
constexpr size_t WS_WDN = WS_WGU + 2ull * 5632 * 1024 * 2;
constexpr size_t WS_HRAW = WS_WDN + 2ull * 1024 * 2816 * 2;
constexpr size_t WS_H = WS_HRAW + 2ull * 2048 * 1024 * 4;
constexpr size_t WS_P = WS_H + (size_t)MTOK * 1024 * 2;
constexpr size_t WS_MIX = WS_P + (size_t)MTOK * 2816 * 2;
constexpr size_t WS_F = WS_MIX + (size_t)MTOK * 1024 * 2;
constexpr size_t WS_END = WS_F + (size_t)MTOK * 1024 * 4;
constexpr size_t OFF_UC = WS_H, OFF_Z = WS_H + 3ull * 256 * MTOK * 2;
constexpr size_t OFF_UT = WS_F, OFF_OA = WS_F + 768ull * MTOK * 2, OFF_LSE = OFF_OA + 2ull * MTOK * 384 * 2;
constexpr size_t EDGE_SZ = 1024ull * 2 * FF * 4;
constexpr size_t OFF_EP = WS_MIX, OFF_EG = WS_MIX + EDGE_SZ, OFF_EU = WS_MIX + 2 * EDGE_SZ;
constexpr int LDS_BYTES = 163840;

struct Args { const float* in[24]; float* out; unsigned char* ws; int ph_lo, ph_hi, coop, pad; };

__device__ __forceinline__ int tidx() { int t = threadIdx.x; asm volatile("" : "+v"(t)); return t; }
__device__ __forceinline__ unsigned pk2(float lo, float hi) { unsigned r; asm("v_cvt_pk_bf16_f32 %0, %1, %2" : "=v"(r) : "v"(lo), "v"(hi)); return r; }
typedef float f32x2v __attribute__((ext_vector_type(2)));
typedef __bf16 bf16v2 __attribute__((ext_vector_type(2)));
__device__ __forceinline__ unsigned pk2n(float lo, float hi) { const f32x2v v = {lo, hi}; const bf16v2 b = __builtin_convertvector(v, bf16v2); return __builtin_bit_cast(unsigned, b); }
__device__ __forceinline__ float bf2f(bf16_t b) { return __uint_as_float(((unsigned)b) << 16); }
__device__ __forceinline__ float bflo(unsigned w) { return __uint_as_float(w << 16); }
__device__ __forceinline__ float bfhi(unsigned w) { return __uint_as_float(w & 0xffff0000u); }
__device__ __forceinline__ float wave_sum(float v) {
#pragma unroll
    for (int o = 1; o < 64; o <<= 1) v += __shfl_xor(v, o);
    return v;
}
__device__ __forceinline__ float fexp2(float x) { return __builtin_amdgcn_exp2f(x); }
__device__ __forceinline__ float gelu_tanh_mul(float x, float up) {
    constexpr float C1 = -2.0f * 0.7978845608028654f * LOG2E, C3 = C1 * 0.044715f;
    const float p = __builtin_fmaf(x * x, C3, C1);
    const float e = fexp2(x * p);
    return (x * up) * __builtin_amdgcn_rcpf(1.0f + e);
}
__device__ __forceinline__ float gelu_tanh(float x) {
    const float u = x * (1.0f + 0.044715f * x * x);
    const float e = fexp2(-2.0f * 0.7978845608028654f * LOG2E * u);
    return x * __builtin_amdgcn_rcpf(1.0f + e);
}

namespace pg8 {
constexpr int BM = 256, BK = 64, HALF = 128, HTB = HALF * BK * 2, STAGE_BYTES = 8 * HTB, NXCD = 8, WGM = 8;
__device__ __forceinline__ int lds_byte(int r, int c) { const int st = (r >> 4) * 2 + (c >> 5), rr = r & 15, cc = c & 31, ob = rr * 64 + cc * 2; return st * 1024 + (ob ^ (((ob >> 9) & 1) << 5)); }
__device__ __forceinline__ void stage_rc(int b, int& R, int& C) { const int st = b / 1024, sb = b % 1024, swz = sb ^ (((sb >> 9) & 1) << 5); R = (st >> 1) * 16 + swz / 64; C = (st & 1) * 32 + (swz % 64) / 2; }
struct Unit { int pm, pn; };
struct Gemm { const bf16_t* A; const bf16_t* Bt; int M, N, K; };
struct StaticOrder {
    int nM, nN, nwg, G, c;
    __device__ void init(int M, int N, int G_, int c_) { nM = M / BM; nN = N / BM; nwg = nM * nN; G = G_; c = c_; }
    __device__ __forceinline__ bool next(int i, Unit& u) const {
        const long L = (long)i * G + c; if (L >= nwg) return false;
        int wgid = (int)L; { const int q = nwg / NXCD, r = nwg % NXCD, xcd = wgid % NXCD, off = wgid / NXCD; wgid = (xcd < r ? xcd * (q + 1) : r * (q + 1) + (xcd - r) * q) + off; }
        const int nig = WGM * nN, gid = wgid / nig, fm = gid * WGM, gsz = (nM - fm) < WGM ? (nM - fm) : WGM;
        u.pm = fm + ((wgid % nig) % gsz); u.pn = (wgid % nig) / gsz; return true;
    }
};
struct PanelOrder {
    int pm;
    __device__ __forceinline__ bool next(int i, Unit& u) const { if (i >= 4) return false; u.pm = pm; u.pn = i; return true; }
};

template <class Epi, class Sched>
__device__ __forceinline__ void gemm_phase(LAS unsigned char* lds, const Gemm g, const Sched& S, const Epi& E) {
    const int tid = tidx(), wid = __builtin_amdgcn_readfirstlane(tid >> 6), lane = tid & 63, wr = wid >> 2, wc = wid & 3, fr = lane & 15, fq = lane >> 4;
    const int K = g.K, nt = K / BK;
    unsigned voffA[2], voffB[2];
#pragma unroll
    for (int i = 0; i < 2; ++i) { int R, C; stage_rc(tid * 16 + i * 8192, R, C); voffA[i] = (unsigned)(R * K + C) * 2u; voffB[i] = voffA[i]; }
    const size_t kstep = (size_t)(BK * 2);
    const size_t hstep = (size_t)HALF * K * 2;
    const size_t tstep = 2 * hstep;
    const unsigned ldsw = (unsigned)wid * 1024u;
    const int aoff = lds_byte(wr * 64 + fr, fq * 8), boff = lds_byte(wc * 32 + fr, fq * 8);
#define PG8_SA(b, h) (((b) * 2 + (h)) * HTB)
#define PG8_SB(b, h) ((4 + (b) * 2 + (h)) * HTB)
#define PG8_STAGE(bufoff, gbase, voff) do { _Pragma("unroll") for (int _i = 0; _i < 2; ++_i) \
        __builtin_amdgcn_global_load_lds((const unsigned*)((const char*)(gbase) + (voff)[_i]), (LAS unsigned*)(lds + (bufoff) + ldsw + _i * 8192), 16, 0, 0); } while (0)
#define PG8_LDA(dst, b, h) do { _Pragma("unroll") for (int m = 0; m < 4; ++m) _Pragma("unroll") for (int k = 0; k < 2; ++k) dst[m][k] = *(const LAS bf16x8*)(lds + PG8_SA(b, h) + aoff + m * 2048 + k * 1024); } while (0)
#define PG8_LDB(dst, b, h) do { _Pragma("unroll") for (int n = 0; n < 2; ++n) _Pragma("unroll") for (int k = 0; k < 2; ++k) dst[n][k] = *(const LAS bf16x8*)(lds + PG8_SB(b, h) + boff + n * 2048 + k * 1024); } while (0)
#define PG8_MMA(ai, bj, At, Bt) do { __builtin_amdgcn_s_setprio(1); _Pragma("unroll") for (int m = 0; m < 4; ++m) _Pragma("unroll") for (int n = 0; n < 2; ++n) _Pragma("unroll") for (int k = 0; k < 2; ++k) \
        acc[ai][bj][m][n] = __builtin_amdgcn_mfma_f32_16x16x32_bf16(Bt[n][k], At[m][k], acc[ai][bj][m][n], 0, 0, 0); __builtin_amdgcn_s_setprio(0); } while (0)
#define PG8_WAIT_V(n) asm volatile("s_waitcnt vmcnt(" #n ")" ::: "memory")
#define PG8_WAIT_L(n) asm volatile("s_waitcnt lgkmcnt(" #n ")" ::: "memory")
#define PG8_BAR __builtin_amdgcn_s_barrier()
#define PG8_SCHED __builtin_amdgcn_sched_barrier(0)
    Unit cur, nxt; int ui = 0;
    if (!S.next(0, cur)) return;
    f32x4 acc[2][2][4][2];
#pragma unroll
    for (int a = 0; a < 2; ++a)
#pragma unroll
        for (int b = 0; b < 2; ++b)
#pragma unroll
            for (int m = 0; m < 4; ++m)
#pragma unroll
                for (int n = 0; n < 2; ++n) acc[a][b][m][n] = (f32x4){0.f, 0.f, 0.f, 0.f};
    bf16x8 At[4][2], B0[2][2], B1[2][2];
    const char* cA = (const char*)g.A + (size_t)cur.pm * tstep; const char* cB = (const char*)g.Bt + (size_t)cur.pn * tstep;
    PG8_STAGE(PG8_SB(0, 0), cB, voffB); PG8_STAGE(PG8_SA(0, 0), cA, voffA); PG8_STAGE(PG8_SB(0, 1), cB + hstep, voffB); PG8_STAGE(PG8_SA(0, 1), cA + hstep, voffA);
    if (wr == 1) PG8_BAR;
    PG8_WAIT_V(4); PG8_BAR;
    PG8_STAGE(PG8_SB(1, 0), cB + kstep, voffB); PG8_STAGE(PG8_SA(1, 0), cA + kstep, voffA); PG8_STAGE(PG8_SB(1, 1), cB + hstep + kstep, voffB);
    PG8_WAIT_V(6); PG8_BAR;
    for (;;) {
        const bool has_next = S.next(ui + 1, nxt);
        const char* nA = has_next ? (const char*)g.A + (size_t)nxt.pm * tstep : cA; const char* nB = has_next ? (const char*)g.Bt + (size_t)nxt.pn * tstep : cB;
        for (int t = 0; t < nt; t += 2) {
            const bool last = (t == nt - 2);
            const char* a1 = cA + (size_t)(t + 1) * kstep;
            const char* a2 = last ? nA : cA + (size_t)(t + 2) * kstep; const char* b2 = last ? nB : cB + (size_t)(t + 2) * kstep;
            const char* a3 = a2 + kstep; const char* b3 = b2 + kstep;
            PG8_LDB(B0, 0, 0); PG8_SCHED; PG8_LDA(At, 0, 0); PG8_STAGE(PG8_SA(1, 1), a1 + hstep, voffA);
            PG8_WAIT_L(8); PG8_BAR; PG8_WAIT_L(0); PG8_MMA(0, 0, At, B0); PG8_BAR; PG8_SCHED;
            PG8_LDB(B1, 0, 1); PG8_STAGE(PG8_SB(0, 0), b2, voffB);
            PG8_BAR; PG8_WAIT_L(0); PG8_MMA(0, 1, At, B1); PG8_BAR;
            PG8_LDA(At, 0, 1); PG8_STAGE(PG8_SA(0, 0), a2, voffA);
            PG8_BAR; PG8_WAIT_L(0); PG8_MMA(1, 0, At, B0); PG8_BAR; PG8_SCHED;
            PG8_STAGE(PG8_SB(0, 1), b2 + hstep, voffB);
            PG8_WAIT_V(6); PG8_BAR; PG8_MMA(1, 1, At, B1); PG8_BAR;
            PG8_LDB(B0, 1, 0); PG8_SCHED; PG8_LDA(At, 1, 0); PG8_STAGE(PG8_SA(0, 1), a2 + hstep, voffA);
            PG8_WAIT_L(8); PG8_BAR; PG8_WAIT_L(0); PG8_MMA(0, 0, At, B0); PG8_BAR; PG8_SCHED;
            PG8_LDB(B1, 1, 1); PG8_STAGE(PG8_SB(1, 0), b3, voffB);
            PG8_BAR; PG8_WAIT_L(0); PG8_MMA(0, 1, At, B1); PG8_BAR;
            PG8_LDA(At, 1, 1); PG8_STAGE(PG8_SA(1, 0), a3, voffA);
            PG8_BAR; PG8_WAIT_L(0); PG8_MMA(1, 0, At, B0); PG8_BAR; PG8_SCHED;
            PG8_STAGE(PG8_SB(1, 1), b3 + hstep, voffB);
            PG8_WAIT_V(6); PG8_BAR; PG8_MMA(1, 1, At, B1); PG8_BAR;
        }
        E(acc, cur, wr, wc, fr, fq);
        if (!has_next) break;
#pragma unroll
        for (int a = 0; a < 2; ++a)
#pragma unroll
            for (int b = 0; b < 2; ++b)
#pragma unroll
                for (int m = 0; m < 4; ++m)
#pragma unroll
                    for (int n = 0; n < 2; ++n) acc[a][b][m][n] = (f32x4){0.f, 0.f, 0.f, 0.f};
        cur = nxt; cA = nA; cB = nB; ++ui;
    }
    PG8_WAIT_V(0);
    if (wr == 0) PG8_BAR;
    PG8_BAR;
#undef PG8_SA
#undef PG8_SB
#undef PG8_STAGE
#undef PG8_LDA
#undef PG8_LDB
#undef PG8_MMA
#undef PG8_WAIT_V
#undef PG8_WAIT_L
#undef PG8_BAR
#undef PG8_SCHED
}
}
using pg8::Unit;

struct EpiIn {
    bf16_t* P; bf16_t* UT; const float* rac; const float* ras; const float* rcc; const float* rcs; const float* gq; const float* gk; LAS unsigned char* scr;
    __device__ __forceinline__ void operator()(const f32x4 (&acc)[2][2][4][2], const Unit& uu, int wr, int wc, int fr, int fq) const {
        Unit u = uu; asm volatile("" : "+s"(u.pm), "+s"(u.pn), "+v"(fr), "+v"(fq));
        const int ch = 4 * u.pn + wc;
        const int rowb = u.pm * 256 + wr * 64 + fr;
        if (ch < 12) {
            const float qs = (ch < 6) ? 0.125f * LOG2E : 1.0f;
#pragma unroll
            for (int ai = 0; ai < 2; ++ai)
#pragma unroll
                for (int m = 0; m < 4; ++m) {
                    const int r = rowb + 128 * ai + 16 * m, s = r & 2047;
                    u32x4 w1, w2;
                    {
                        const f32x4 c0 = *(const f32x4*)(rac + s * 32 + 8 * fq), s0 = *(const f32x4*)(ras + s * 32 + 8 * fq);
                        const f32x4 c1 = *(const f32x4*)(rac + s * 32 + 8 * fq + 4), s1 = *(const f32x4*)(ras + s * 32 + 8 * fq + 4);
                        const f32x4 x10 = acc[ai][0][m][0], x11 = acc[ai][0][m][1], x20 = acc[ai][1][m][0], x21 = acc[ai][1][m][1];
                        const f32x4 a0 = (x10 * c0 - x20 * s0) * qs, a1 = (x11 * c1 - x21 * s1) * qs;
                        const f32x4 b0 = (x20 * c0 + x10 * s0) * qs, b1 = (x21 * c1 + x11 * s1) * qs;
                        w1.x = pk2(a0[0], a0[1]); w1.y = pk2(a0[2], a0[3]); w1.z = pk2(a1[0], a1[1]); w1.w = pk2(a1[2], a1[3]);
                        w2.x = pk2(b0[0], b0[1]); w2.y = pk2(b0[2], b0[3]); w2.z = pk2(b1[0], b1[1]); w2.w = pk2(b1[2], b1[3]);
                    }
                    bf16_t* dst = P + (size_t)r * PW + 64 * ch + 8 * fq;
                    *(u32x4*)dst = w1; *(u32x4*)(dst + 32) = w2;
                }
        } else if (ch < 18 || ch >= 38) {
#pragma unroll
            for (int ai = 0; ai < 2; ++ai)
#pragma unroll
                for (int m = 0; m < 4; ++m) {
                    const int r = rowb + 128 * ai + 16 * m;
                    bf16_t* dst = P + (size_t)r * PW + 64 * ch + 8 * fq;
#pragma unroll
                    for (int bj = 0; bj < 2; ++bj) {
                        const f32x4 v0 = acc[ai][bj][m][0], v1 = acc[ai][bj][m][1];
                        u32x4 w; w.x = pk2(v0[0], v0[1]); w.y = pk2(v0[2], v0[3]); w.z = pk2(v1[0], v1[1]); w.w = pk2(v1[2], v1[3]);
                        *(u32x4*)(dst + 32 * bj) = w;
                    }
                }
        } else if (ch < 30) {
            const int wid = wr * 4 + wc, lane = fq * 16 + fr;
            LAS unsigned char* T = scr + wid * 4096;
#pragma unroll
            for (int ai = 0; ai < 2; ++ai)
#pragma unroll
                for (int bj = 0; bj < 2; ++bj) {
#pragma unroll
                    for (int m = 0; m < 4; ++m)
#pragma unroll
                        for (int n = 0; n < 2; ++n)
#pragma unroll
                            for (int j = 0; j < 4; ++j) {
                                const int chl = 8 * fq + 4 * n + j, rl = 16 * m + fr;
                                *(LAS bf16_t*)(T + chl * 128 + rl * 2) = (bf16_t)(pk2(acc[ai][bj][m][n][j], 0.f) & 0xffffu);
                            }
                    asm volatile("s_waitcnt lgkmcnt(0)" ::: "memory");
                    const int r0 = u.pm * 256 + 128 * ai + 64 * wr;
                    const int hc0 = 64 * (ch - 18) + 32 * bj;
#pragma unroll
                    for (int q = 0; q < 4; ++q) {
                        const int idx = q * 64 + lane, chl = idx >> 3, k = idx & 7;
                        const u32x4 v = *(const LAS u32x4*)(T + chl * 128 + k * 16);
                        *(u32x4*)(UT + (size_t)(hc0 + chl) * MTOK + r0 + 8 * k) = v;
                    }
                    asm volatile("s_waitcnt lgkmcnt(0)" ::: "memory");
                }
        } else {
            const float* g = (ch < 36) ? gq : gk;
            const float qs = (ch < 36) ? 0.125f * LOG2E : 1.0f;
            f32x4 g4[2][2];
#pragma unroll
            for (int bj = 0; bj < 2; ++bj)
#pragma unroll
                for (int n = 0; n < 2; ++n) g4[bj][n] = *(const f32x4*)(g + 32 * bj + 16 * n + 4 * fq);
#pragma unroll
            for (int ai = 0; ai < 2; ++ai)
#pragma unroll
                for (int m = 0; m < 4; ++m) {
                    const int r = rowb + 128 * ai + 16 * m, s = r & 2047;
                    float ss = 0.f;
#pragma unroll
                    for (int bj = 0; bj < 2; ++bj)
#pragma unroll
                        for (int n = 0; n < 2; ++n) { const f32x4 x = acc[ai][bj][m][n]; ss += (x[0] * x[0] + x[1] * x[1]) + (x[2] * x[2] + x[3] * x[3]); }
                    ss += __shfl_xor(ss, 16); ss += __shfl_xor(ss, 32);
                    const float rstd = rsqrtf(ss * (1.0f / 64.0f) + EPS) * qs;
                    bf16_t* dst = P + (size_t)r * PW + 64 * ch + 8 * fq;
#pragma unroll
                    for (int bj = 0; bj < 2; ++bj) {
                        const int pos = bj ? (s & 63) : (s >> 6);
                        const f32x4 c = *(const f32x4*)(rcc + pos * 16 + 4 * fq), sn = *(const f32x4*)(rcs + pos * 16 + 4 * fq);
                        const f32x4 x1 = acc[ai][bj][m][0] * g4[bj][0] * rstd, x2 = acc[ai][bj][m][1] * g4[bj][1] * rstd;
                        const f32x4 o1 = x1 * c - x2 * sn, o2 = x2 * c + x1 * sn;
                        u32x4 w; w.x = pk2(o1[0], o1[1]); w.y = pk2(o1[2], o1[3]); w.z = pk2(o2[0], o2[1]); w.w = pk2(o2[2], o2[3]);
                        *(u32x4*)(dst + 32 * bj) = w;
                    }
                }
        }
    }
};

struct EpiF {
    bf16_t* F;
    __device__ __forceinline__ void operator()(const f32x4 (&acc)[2][2][4][2], const Unit& uu, int wr, int wc, int fr, int fq) const {
        Unit u = uu; asm volatile("" : "+s"(u.pm), "+s"(u.pn), "+v"(fr), "+v"(fq));
        const int row0 = u.pm * 256 + wr * 64 + fr, col0 = u.pn * 256 + wc * 32 + 8 * fq;
#pragma unroll
        for (int ai = 0; ai < 2; ++ai)
#pragma unroll
            for (int m = 0; m < 4; ++m) {
                bf16_t* rowp = F + (size_t)(row0 + ai * 128 + m * 16) * DM + col0;
#pragma unroll
                for (int bj = 0; bj < 2; ++bj) {
                    const f32x4 v0 = acc[ai][bj][m][0], v1 = acc[ai][bj][m][1];
                    u32x4 w; w.x = pk2(v0[0], v0[1]); w.y = pk2(v0[2], v0[3]); w.z = pk2(v1[0], v1[1]); w.w = pk2(v1[2], v1[3]);
                    *(u32x4*)(rowp + bj * 128) = w;
                }
            }
    }
};

struct EpiGU {
    bf16_t* ACT; float* EP; float* EG; float* EU; const float* cw; const float* cb;
    __device__ __forceinline__ void operator()(const f32x4 (&acc)[2][2][4][2], const Unit& uu, int wr, int wc, int fr, int fq) const {
        Unit u = uu; asm volatile("" : "+s"(u.pm), "+s"(u.pn), "+v"(fr), "+v"(fq));
        const int chan0 = 128 * u.pn + 32 * wc + 8 * fq;
        const int lane = fq * 16 + fr;
        const int srcU = (lane & 48) | ((fr + 15) & 15), srcD = (lane & 48) | ((fr + 1) & 15);
#pragma unroll
        for (int ai = 0; ai < 2; ++ai) {
            const int Rg = u.pm * 256 + 128 * ai + 64 * wr;
            const int gi = Rg >> 6;
#pragma unroll
            for (int n = 0; n < 2; ++n) {
                const f32x4 w0 = *(const f32x4*)(cw + chan0 + 4 * n), w1 = *(const f32x4*)(cw + FF + chan0 + 4 * n), w2 = *(const f32x4*)(cw + 2 * FF + chan0 + 4 * n), bb = *(const f32x4*)(cb + chan0 + 4 * n);
                f32x4 av[4], ptop, pbot;
#pragma unroll
                for (int j = 0; j < 4; ++j) {
                    float gv[4], ru[4], rd[4];
#pragma unroll
                    for (int m = 0; m < 4; ++m) { gv[m] = acc[ai][0][m][n][j];
                        ru[m] = __int_as_float(__builtin_amdgcn_update_dpp(0, __float_as_int(gv[m]), 0x121, 0xf, 0xf, false));
                        rd[m] = __int_as_float(__builtin_amdgcn_update_dpp(0, __float_as_int(gv[m]), 0x12f, 0xf, 0xf, false)); }
#pragma unroll
                    for (int m = 0; m < 4; ++m) {
                        const float prev = (fr == 0) ? (m > 0 ? ru[m > 0 ? m - 1 : 0] : 0.f) : ru[m];
                        const float next = (fr == 15) ? (m < 3 ? rd[m < 3 ? m + 1 : 3] : 0.f) : rd[m];
                        const float pre = w0[j] * prev + w1[j] * gv[m] + w2[j] * next + bb[j];
                        av[m][j] = gelu_tanh_mul(pre, acc[ai][1][m][n][j]);
                        if (m == 0) ptop[j] = pre;
                        if (m == 3) pbot[j] = pre;
                    }
                }
                if (fr == 0) { const size_t eo = ((size_t)gi * 2) * FF + chan0 + 4 * n; *(f32x4*)(EP + eo) = ptop; *(f32x4*)(EG + eo) = acc[ai][0][0][n]; *(f32x4*)(EU + eo) = acc[ai][1][0][n]; }
                if (fr == 15) { const size_t eo = ((size_t)gi * 2 + 1) * FF + chan0 + 4 * n; *(f32x4*)(EP + eo) = pbot; *(f32x4*)(EG + eo) = acc[ai][0][3][n]; *(f32x4*)(EU + eo) = acc[ai][1][3][n]; }
#pragma unroll
                for (int m = 0; m < 4; ++m) {
                    const bool edge = ((m == 0) && (fr == 0)) || ((m == 3) && (fr == 15));
                    if (!edge) { u32x2 w; w.x = pk2(av[m][0], av[m][1]); w.y = pk2(av[m][2], av[m][3]); *(u32x2*)(ACT + (size_t)(Rg + 16 * m + fr) * FF + chan0 + 4 * n) = w; }
                }
            }
        }
    }
};

__device__ __forceinline__ int colmap_in(int R) {
    const int T = R >> 8, rt = R & 255, bj = rt >> 7, wc = (rt >> 5) & 3, n = (rt >> 4) & 1, fq = (rt >> 2) & 3, j = rt & 3;
    const int ch = 4 * T + wc;
    const int l = (ch >= 30 && ch < 38) ? (32 * bj + 16 * n + 4 * fq + j) : (32 * bj + 8 * fq + 4 * n + j);
    return 64 * ch + l;
}
template <int MODE>
__device__ __forceinline__ void transpose_item(const Args& a, int layer, int item, LAS float* scr, int lane) {
    constexpr int K = (MODE == 3) ? FF : DM;
    constexpr int NP = (MODE == 0) ? PW : (MODE == 2 ? 2 * FF : DM);
    constexpr int N = (MODE == 0) ? PW : (MODE == 2 ? FF : DM);
    const int nblk = NP / 32, kb = item / nblk, nb = item % nblk, k0 = 64 * kb, n0 = 32 * nb;
    const int R = n0 + (lane & 31);
    const float* src; int col;
    if (MODE == 0) { src = a.in[5] + (size_t)layer * DM * PW; col = colmap_in(R); }
    else if (MODE == 1) { src = a.in[6] + (size_t)layer * DM * DM; col = (R & ~31) + 8 * ((R >> 2) & 3) + 4 * ((R >> 4) & 1) + (R & 3); }
    else if (MODE == 2) {
        const int T = R >> 8, rt = R & 255, bj = rt >> 7, wc = (rt >> 5) & 3, n = (rt >> 4) & 1, fq = (rt >> 2) & 3, j = rt & 3;
        col = 128 * T + 32 * wc + 8 * fq + 4 * n + j; src = (bj ? a.in[20] : a.in[19]) + (size_t)layer * DM * FF;
    } else { src = a.in[23] + (size_t)layer * FF * DM; col = (R & ~31) + 8 * ((R >> 2) & 3) + 4 * ((R >> 4) & 1) + (R & 3); }
    bf16_t* WT = (bf16_t*)(a.ws + (MODE == 0 ? WS_WIN : MODE == 1 ? WS_WOUT : MODE == 2 ? WS_WGU : WS_WDN)) + (size_t)layer * NP * K;
#pragma unroll 8
    for (int i = 0; i < 32; ++i) { const int kk = 2 * i + (lane >> 5); scr[kk * 33 + (lane & 31)] = src[(size_t)(k0 + kk) * N + col]; }
    asm volatile("s_waitcnt lgkmcnt(0)" ::: "memory");
    const int c = lane & 7;
#pragma unroll
    for (int j = 0; j < 4; ++j) {
        const int n = (lane >> 3) + 8 * j; const LAS float* s = scr + (8 * c) * 33 + n;
        u32x4 o; o.x = pk2(s[0 * 33], s[1 * 33]); o.y = pk2(s[2 * 33], s[3 * 33]); o.z = pk2(s[4 * 33], s[5 * 33]); o.w = pk2(s[6 * 33], s[7 * 33]);
        *(u32x4*)(WT + (size_t)(n0 + n) * K + k0 + 8 * c) = o;
    }
    asm volatile("s_waitcnt lgkmcnt(0)" ::: "memory");
}

__device__ __forceinline__ void norm_row(const float* xrow, const float* g, bf16_t* orow, int lane) {
    f32x4 v[4]; float s = 0.f;
#pragma unroll
    for (int j = 0; j < 4; ++j) { v[j] = *(const f32x4*)(xrow + 4 * lane + 256 * j); s += (v[j][0] * v[j][0] + v[j][1] * v[j][1]) + (v[j][2] * v[j][2] + v[j][3] * v[j][3]); }
    const float rstd = rsqrtf(wave_sum(s) * (1.0f / DM) + EPS);
#pragma unroll
    for (int j = 0; j < 4; ++j) {
        const f32x4 gg = *(const f32x4*)(g + 4 * lane + 256 * j); const f32x4 y = v[j] * rstd * gg;
        u32x2 w; w.x = pk2(y[0], y[1]); w.y = pk2(y[2], y[3]); *(u32x2*)(orow + 4 * lane + 256 * j) = w;
    }
}

__device__ __forceinline__ void hyena_raw4(const Args& a, int L, int t0, LAS float* scr, int lane) {
    const float* w1 = a.in[11] + L * 33 * 64; const float* b1 = a.in[12] + L * 64; const float* fr = a.in[13] + L * 128;
    const float* w2 = a.in[14] + L * 64 * 64; const float* b2 = a.in[15] + L * 64; const float* w3 = a.in[16] + (size_t)L * 64 * 1024; const float* dec = a.in[17] + L * 1024;
#pragma unroll 1
    for (int p = 0; p < 4; ++p) {
        const int t = t0 + p;
        LAS float* sp = scr + 192 * p;
        const float tl = (float)t * (1.0f / 2047.0f);
        if (lane < 33) {
            float z;
            if (lane == 0) z = tl;
            else {
                const int k = (lane - 1) & 15;
                const float band = 1e-4f + (float)k * ((15.0f - 1e-4f) / 15.0f);
                const float ang = 2.0f * 3.14159265358979323846f * band * (float)t / 2048.0f;
                z = (lane <= 16) ? cosf(ang) : -sinf(ang);
            }
            sp[lane] = z;
        }
        asm volatile("s_waitcnt lgkmcnt(0)" ::: "memory");
        float h = b1[lane];
        {
            float wv[33];
#pragma unroll
            for (int j = 0; j < 33; ++j) wv[j] = w1[j * 64 + lane];
#pragma unroll
            for (int j = 0; j < 33; ++j) h += sp[j] * wv[j];
        }
        h = sinf(fr[lane] * h);
        sp[64 + lane] = h;
        asm volatile("s_waitcnt lgkmcnt(0)" ::: "memory");
        float h2 = b2[lane];
#pragma unroll 1
        for (int k0 = 0; k0 < 64; k0 += 32) {
            float wv[32];
#pragma unroll
            for (int k = 0; k < 32; ++k) wv[k] = w2[(k0 + k) * 64 + lane];
#pragma unroll
            for (int k = 0; k < 32; ++k) h2 += sp[64 + k0 + k] * wv[k];
        }
        h2 = sinf(fr[64 + lane] * h2);
        sp[128 + lane] = h2;
        asm volatile("s_waitcnt lgkmcnt(0)" ::: "memory");
    }
    float o[4][16];
#pragma unroll
    for (int p = 0; p < 4; ++p)
#pragma unroll
        for (int mth = 0; mth < 16; ++mth) o[p][mth] = 0.f;
#pragma unroll 1
    for (int k0 = 0; k0 < 64; k0 += 4) {
        float wv[4][16];
#pragma unroll
        for (int k = 0; k < 4; ++k)
#pragma unroll
            for (int mth = 0; mth < 16; ++mth) wv[k][mth] = w3[(k0 + k) * 1024 + lane + 64 * mth];
#pragma unroll
        for (int p = 0; p < 4; ++p)
#pragma unroll
            for (int k = 0; k < 4; ++k) { const float hk = scr[192 * p + 128 + k0 + k];
#pragma unroll
                for (int mth = 0; mth < 16; ++mth) o[p][mth] += hk * wv[k][mth]; }
    }
#pragma unroll
    for (int p = 0; p < 4; ++p) {
        const float tl = (float)(t0 + p) * (1.0f / 2047.0f);
        float* raw = (float*)(a.ws + WS_HRAW) + ((size_t)L * 2048 + t0 + p) * 1024;
#pragma unroll
        for (int mth = 0; mth < 16; ++mth) { const int idx = lane + 64 * mth; raw[idx] = o[p][mth] * expf(-tl * dec[idx]); }
    }
    asm volatile("s_waitcnt lgkmcnt(0)" ::: "memory");
}

__device__ __forceinline__ void phase0(const Args& a, LAS unsigned char* lds) {
    const int tid = tidx(), wid = tid >> 6, lane = tid & 63;
    const int gw = blockIdx.x * 8 + wid, NGW = gridDim.x * 8;
    LAS float* scr = (LAS float*)(lds + wid * 16384);
    for (int i = blockIdx.x * 512 + tid; i < 2048 * 32 + 64 * 16; i += gridDim.x * 512) {
        if (i < 2048 * 32) {
            const int s = i >> 5, d = i & 31; const double f = pow(10000.0, -(double)d / 32.0), ang = (double)s * f;
            ((float*)(a.ws + WS_RAC))[i] = (float)cos(ang); ((float*)(a.ws + WS_RAS))[i] = (float)sin(ang);
        } else {
            const int k = i - 2048 * 32, p = k >> 4, d = k & 15; const double f = pow(10000.0, -(double)d / 16.0), ang = (double)p * f;
            ((float*)(a.ws + WS_RCC))[k] = (float)cos(ang); ((float*)(a.ws + WS_RCS))[k] = (float)sin(ang);
        }
    }
    constexpr int I0 = 16 * 80, I1 = 16 * 32, I2 = 16 * 176, I3 = 44 * 32, IL = I0 + I1 + I2 + I3;
    for (int it = gw; it < 2 * IL; it += NGW) {
        const int layer = it / IL; int r = it % IL;
        if (r < I0) { transpose_item<0>(a, layer, r, scr, lane); continue; } r -= I0;
        if (r < I1) { transpose_item<1>(a, layer, r, scr, lane); continue; } r -= I1;
        if (r < I2) { transpose_item<2>(a, layer, r, scr, lane); continue; } r -= I2;
        transpose_item<3>(a, layer, r, scr, lane);
    }
    for (int it = gw; it < 2 * 512; it += NGW) hyena_raw4(a, it >> 9, (it & 511) * 4, scr, lane);
    for (int r = gw * 32; r < MTOK; r += NGW * 32) {
#pragma unroll 1
        for (int k = 0; k < 32; k += 4) {
            f32x4 v[4][4];
#pragma unroll
            for (int u = 0; u < 4; ++u)
#pragma unroll
                for (int j = 0; j < 4; ++j) v[u][j] = *(const f32x4*)(a.in[0] + (size_t)(r + k + u) * DM + 4 * lane + 256 * j);
#pragma unroll
            for (int u = 0; u < 4; ++u) {
                float s = 0.f;
#pragma unroll
                for (int j = 0; j < 4; ++j) s += (v[u][j][0] * v[u][j][0] + v[u][j][1] * v[u][j][1]) + (v[u][j][2] * v[u][j][2] + v[u][j][3] * v[u][j][3]);
                const float rstd = rsqrtf(wave_sum(s) * (1.0f / DM) + EPS);
                bf16_t* orow = (bf16_t*)(a.ws + WS_H) + (size_t)(r + k + u) * DM;
#pragma unroll
                for (int j = 0; j < 4; ++j) { const f32x4 gg = *(const f32x4*)(a.in[1] + 4 * lane + 256 * j); const f32x4 y = v[u][j] * rstd * gg; u32x2 w; w.x = pk2(y[0], y[1]); w.y = pk2(y[2], y[3]); *(u32x2*)(orow + 4 * lane + 256 * j) = w; }
            }
        }
    }
}

__device__ __forceinline__ void gload32(u32x4 (&r)[4], const unsigned char* ubase, unsigned pitch, int lane) {
#pragma unroll
    for (int i = 0; i < 4; ++i) { const unsigned rr = (unsigned)(lane >> 3) + 8u * i; r[i] = *(const u32x4*)(ubase + rr * pitch + (unsigned)(lane & 7) * 16u); }
}
template <bool SWZ>
__device__ __forceinline__ void lwrite32(LAS unsigned char* dst, const u32x4 (&r)[4], int lane) {
#pragma unroll
    for (int i = 0; i < 4; ++i) { const int rr = (lane >> 3) + 8 * i; const int pc = SWZ ? ((lane & 7) ^ ((rr >> 1) & 7)) : (lane & 7); *(LAS u32x4*)(dst + rr * 128 + pc * 16) = r[i]; }
}
__device__ __forceinline__ void load_kf(LAS const unsigned char* kb, bf16x8 (&kf)[4], int lane) {
    const int kl = lane & 31, h = lane >> 5;
#pragma unroll
    for (int s = 0; s < 4; ++s) { const int pc = (2 * s + h) ^ ((kl >> 1) & 7); kf[s] = *(const LAS bf16x8*)(kb + kl * 128 + pc * 16); }
}
__device__ __forceinline__ void load_vf(LAS const unsigned char* vb, bf16x8 (&vf)[2][2], int lane) {
    const int h = lane >> 5, i16 = lane & 15, q = i16 >> 2, p = i16 & 3, dbase = ((lane >> 4) & 1) * 16;
#pragma unroll
    for (int s2 = 0; s2 < 2; ++s2)
#pragma unroll
        for (int dt = 0; dt < 2; ++dt) {
            const int key = 16 * s2 + 4 * h + q, d0 = 32 * dt + dbase + 4 * p;
            const bf16x4 lo = __builtin_amdgcn_ds_read_tr16_b64_v4i16((LAS bf16x4*)(vb + key * 128 + d0 * 2));
            const bf16x4 hi = __builtin_amdgcn_ds_read_tr16_b64_v4i16((LAS bf16x4*)(vb + (key + 8) * 128 + d0 * 2));
            vf[s2][dt] = (bf16x8){lo[0], lo[1], lo[2], lo[3], hi[0], hi[1], hi[2], hi[3]};
        }
}
template <bool KLDS>
__device__ __forceinline__ void attn_step(const bf16x8 (&kf)[4], LAS const unsigned char* kb, const bf16x8 (&vf)[2][2], const bf16x8 (&qf)[4], f32x16& o0, f32x16& o1, float& m, float& l, int lane, int maskmode) {
    const int ql = lane & 31, h = lane >> 5;
    f32x16 S;
#pragma unroll
    for (int i = 0; i < 16; ++i) S[i] = 0.f;
#pragma unroll
    for (int s = 0; s < 4; ++s) {
        if (KLDS) { const int pc = (2 * s + h) ^ ((ql >> 1) & 7); const bf16x8 k1 = *(const LAS bf16x8*)(kb + ql * 128 + pc * 16); S = __builtin_amdgcn_mfma_f32_32x32x16_bf16(k1, qf[s], S, 0, 0, 0); }
        else S = __builtin_amdgcn_mfma_f32_32x32x16_bf16(kf[s], qf[s], S, 0, 0, 0);
    }
    if (maskmode) {
#pragma unroll
        for (int i = 0; i < 16; ++i) { const int kr = (i & 3) + 8 * (i >> 2) + 4 * h; const bool ok = (maskmode == 1) ? (kr >= ql) : (kr <= ql); S[i] = ok ? S[i] : -1e30f; }
    }
    float tm = S[0];
#pragma unroll
    for (int i = 1; i < 16; ++i) tm = fmaxf(tm, S[i]);
    tm = fmaxf(tm, __shfl_xor(tm, 32));
    const float mn = fmaxf(m, tm), al = fexp2(m - mn); m = mn;
    float ps = 0.f;
#pragma unroll
    for (int i = 0; i < 16; ++i) { S[i] = fexp2(S[i] - mn); ps += S[i]; }
    l = l * al + ps;
#pragma unroll
    for (int i = 0; i < 16; ++i) { o0[i] *= al; o1[i] *= al; }
    bf16x8 pf[2];
#pragma unroll
    for (int s2 = 0; s2 < 2; ++s2) {
        u32x4 w; w.x = pk2n(S[8 * s2 + 0], S[8 * s2 + 1]); w.y = pk2n(S[8 * s2 + 2], S[8 * s2 + 3]); w.z = pk2n(S[8 * s2 + 4], S[8 * s2 + 5]); w.w = pk2n(S[8 * s2 + 6], S[8 * s2 + 7]);
        pf[s2] = __builtin_bit_cast(bf16x8, w);
    }
#pragma unroll
    for (int s2 = 0; s2 < 2; ++s2) {
        o0 = __builtin_amdgcn_mfma_f32_32x32x16_bf16(vf[s2][0], pf[s2], o0, 0, 0, 0);
        o1 = __builtin_amdgcn_mfma_f32_32x32x16_bf16(vf[s2][1], pf[s2], o1, 0, 0, 0);
    }
}

__device__ __forceinline__ void attnA_unit(const Args& a, int unit, LAS unsigned char* lds) {
    const int tid = tidx(), wid = __builtin_amdgcn_readfirstlane(tid >> 6), lane = tid & 63, ql = lane & 31, h = lane >> 5;
    const int b = unit / 24, rem = unit % 24, hh = rem >> 2, blk = rem & 3;
    const bf16_t* P = (const bf16_t*)(a.ws + WS_P);
    bf16_t* OA = (bf16_t*)(a.ws + OFF_OA); float* LSE = (float*)(a.ws + OFF_LSE); bf16_t* MIX = (bf16_t*)(a.ws + WS_MIX);
    LAS unsigned char* wl = lds + wid * 8192;
    const unsigned char* kbase = (const unsigned char*)(P + (size_t)b * SEQ * PW + 384 + 64 * hh);
    const unsigned char* vbase = (const unsigned char*)(P + (size_t)b * SEQ * PW + 768 + 64 * hh);
#pragma unroll 1
    for (int pidx = 0; pidx < 3; ++pidx) {
        const int dl = (pidx == 0) ? 1 : (pidx == 1 ? 4 : 16), Ls = SEQ / dl;
        if (pidx == 2) { __syncthreads(); }
#pragma unroll 1
        for (int e = 0; e < 2; ++e) {
            const int qt = 2 * wid + e, r = qt % dl, i0 = (512 * blk) / dl + 32 * (qt / dl);
            const int tq = dl * (i0 + ql) + r;
            bf16x8 qf[4];
            { const bf16_t* qp = P + ((size_t)b * SEQ + tq) * PW + 64 * hh + 8 * h;
#pragma unroll
              for (int s = 0; s < 4; ++s) qf[s] = *(const bf16x8*)(qp + 16 * s); }
            f32x16 o0, o1;
#pragma unroll
            for (int i = 0; i < 16; ++i) { o0[i] = 0.f; o1[i] = 0.f; }
            float m = -1e30f, l = 0.f;
            int kt0 = 0, kt1 = 4;
            if (i0 - 64 < 0) kt0 = (i0 - 32 < 0) ? 2 : 1;
            if (i0 + 64 >= Ls) kt1 = (i0 + 32 >= Ls) ? 2 : 3;
            const unsigned pitch = (unsigned)dl * (PW * 2);
            u32x4 pk[4], pv[4];
            { const size_t ro = (size_t)(dl * (i0 - 64 + 32 * kt0) + r) * (PW * 2); gload32(pk, kbase + ro, pitch, lane); gload32(pv, vbase + ro, pitch, lane); }
#pragma unroll 1
            for (int kt = kt0; kt <= kt1; ++kt) {
                asm volatile("" ::: "memory");
                lwrite32<true>(wl, pk, lane); lwrite32<false>(wl + 4096, pv, lane);
                if (kt < kt1) { const size_t ro = (size_t)(dl * (i0 - 64 + 32 * (kt + 1)) + r) * (PW * 2); gload32(pk, kbase + ro, pitch, lane); gload32(pv, vbase + ro, pitch, lane); }
                asm volatile("s_waitcnt lgkmcnt(0)" ::: "memory");
                bf16x8 kf[4], vf[2][2];
                load_kf(wl, kf, lane); load_vf(wl + 4096, vf, lane);
                attn_step<false>(kf, wl, vf, qf, o0, o1, m, l, lane, kt == 0 ? 1 : (kt == 4 ? 2 : 0));
                asm volatile("" ::: "memory");
            }
            const float lt = l + __shfl_xor(l, 32);
            const float inv = 1.0f / lt, lse = m + __builtin_amdgcn_logf(lt);
            const size_t tokg = (size_t)b * SEQ + tq;
            if (pidx < 2) {
                bf16_t* op = OA + ((size_t)pidx * MTOK + tokg) * 384 + 64 * hh;
#pragma unroll
                for (int dt = 0; dt < 2; ++dt)
#pragma unroll
                    for (int g = 0; g < 4; ++g) {
                        const f32x16& o = dt ? o1 : o0;
                        u32x2 w; w.x = pk2(o[4 * g] * inv, o[4 * g + 1] * inv); w.y = pk2(o[4 * g + 2] * inv, o[4 * g + 3] * inv);
                        *(u32x2*)(op + 32 * dt + 8 * g + 4 * h) = w;
                    }
                if (h == 0) LSE[((size_t)pidx * MTOK + tokg) * 6 + hh] = lse;
            } else {
                const float l1 = LSE[tokg * 6 + hh], l2 = LSE[((size_t)MTOK + tokg) * 6 + hh];
                const float mx = fmaxf(lse, fmaxf(l1, l2));
                const float w1 = fexp2(l1 - mx), w2 = fexp2(l2 - mx), w3 = fexp2(lse - mx);
                const float wi = 1.0f / (w1 + w2 + w3);
                const float c1 = w1 * wi, c2 = w2 * wi, c3 = w3 * wi * inv;
                const bf16_t* p1 = OA + tokg * 384 + 64 * hh; const bf16_t* p2 = OA + ((size_t)MTOK + tokg) * 384 + 64 * hh;
                bf16_t* op = MIX + tokg * DM + 64 * hh;
#pragma unroll
                for (int dt = 0; dt < 2; ++dt)
#pragma unroll
                    for (int g = 0; g < 4; ++g) {
                        const f32x16& o = dt ? o1 : o0;
                        const int d = 32 * dt + 8 * g + 4 * h;
                        const u32x2 a1 = *(const u32x2*)(p1 + d), a2 = *(const u32x2*)(p2 + d);
                        const float r0 = c1 * bflo(a1.x) + c2 * bflo(a2.x) + c3 * o[4 * g], r1 = c1 * bfhi(a1.x) + c2 * bfhi(a2.x) + c3 * o[4 * g + 1];
                        const float r2 = c1 * bflo(a1.y) + c2 * bflo(a2.y) + c3 * o[4 * g + 2], r3 = c1 * bfhi(a1.y) + c2 * bfhi(a2.y) + c3 * o[4 * g + 3];
                        u32x2 w; w.x = pk2(r0, r1); w.y = pk2(r2, r3);
                        *(u32x2*)(op + d) = w;
                    }
            }
        }
    }
}

__device__ __forceinline__ void attnC_unit(const Args& a, int unit, LAS unsigned char* lds) {
    const int tid = tidx(), wid = __builtin_amdgcn_readfirstlane(tid >> 6), lane = tid & 63, ql = lane & 31, h = lane >> 5;
    const int b = unit / 24, rem = unit % 24, hq = rem >> 2, qb = rem & 3, g = hq / 3;
    const bf16_t* P = (const bf16_t*)(a.ws + WS_P);
    bf16_t* MIX = (bf16_t*)(a.ws + WS_MIX);
    const int srow = tid >> 3, sch = tid & 7;
    const unsigned char* kg = (const unsigned char*)(P + ((size_t)b * SEQ + srow) * PW + CK0 + 64 * g) + sch * 16;
    const unsigned char* vg = (const unsigned char*)(P + ((size_t)b * SEQ + srow) * PW + CV0 + 64 * g) + sch * 16;
    const int kwo = srow * 128 + ((sch ^ ((srow >> 1) & 7)) * 16), vwo = 8192 + srow * 128 + sch * 16;
    const size_t tok0 = (size_t)b * SEQ + 512 * qb + 64 * wid + ql;
    bf16x8 qf[2][4]; f32x16 o0[2], o1[2]; float m[2], l[2];
#pragma unroll
    for (int e = 0; e < 2; ++e) {
        const bf16_t* qp = P + (tok0 + 32 * e) * PW + CQ0 + 64 * hq + 8 * h;
#pragma unroll
        for (int s = 0; s < 4; ++s) qf[e][s] = *(const bf16x8*)(qp + 16 * s);
#pragma unroll
        for (int i = 0; i < 16; ++i) { o0[e][i] = 0.f; o1[e][i] = 0.f; }
        m[e] = -1e30f; l[e] = 0.f;
    }
    constexpr size_t TSTEP = (size_t)64 * PW * 2;
    u32x4 rk = *(const u32x4*)kg, rv = *(const u32x4*)vg;
    __syncthreads();
    *(LAS u32x4*)(lds + kwo) = rk; *(LAS u32x4*)(lds + vwo) = rv;
    rk = *(const u32x4*)(kg + TSTEP); rv = *(const u32x4*)(vg + TSTEP);
    __syncthreads();
#pragma unroll 1
    for (int kt = 0; kt < 32; ++kt) {
        LAS unsigned char* cur = lds + (kt & 1) * 16384;
        LAS unsigned char* nxt = lds + ((kt + 1) & 1) * 16384;
        if (kt + 1 < 32) { *(LAS u32x4*)(nxt + kwo) = rk; *(LAS u32x4*)(nxt + vwo) = rv; }
        if (kt + 2 < 32) { rk = *(const u32x4*)(kg + (size_t)(kt + 2) * TSTEP); rv = *(const u32x4*)(vg + (size_t)(kt + 2) * TSTEP); }
#pragma unroll
        for (int j = 0; j < 2; ++j) {
            bf16x8 kf[4], vf[2][2];
            load_kf(cur + j * 4096, kf, lane); load_vf(cur + 8192 + j * 4096, vf, lane);
#pragma unroll
            for (int e = 0; e < 2; ++e) attn_step<false>(kf, cur, vf, qf[e], o0[e], o1[e], m[e], l[e], lane, 0);
        }
        __syncthreads();
    }
#pragma unroll
    for (int e = 0; e < 2; ++e) {
        const float lt = l[e] + __shfl_xor(l[e], 32), inv = 1.0f / lt;
        bf16_t* op = MIX + (tok0 + 32 * e) * DM + 640 + 64 * hq;
#pragma unroll
        for (int dt = 0; dt < 2; ++dt)
#pragma unroll
            for (int gg = 0; gg < 4; ++gg) {
                const f32x16& oo = dt ? o1[e] : o0[e];
                u32x2 w; w.x = pk2(oo[4 * gg] * inv, oo[4 * gg + 1] * inv); w.y = pk2(oo[4 * gg + 2] * inv, oo[4 * gg + 3] * inv);
                *(u32x2*)(op + 32 * dt + 8 * gg + 4 * h) = w;
            }
    }
}

constexpr int HY_CP = 8192 + 16;
__device__ __forceinline__ void hy_filter(const Args& a, int L, int order, int c, LAS unsigned char* lds) {
    const int tid = tidx();
    LAS float* tmp = (LAS float*)(lds + 66048);
    LAS float* red = (LAS float*)(lds + 66048 + 16384);
    const float* raw = (const float*)(a.ws + WS_HRAW) + (size_t)L * 2048 * 1024 + order * 512 + c;
    float s = 0.f;
    for (int i = tid; i < 4096; i += 512) {
        float v;
        if (i < 2048) v = raw[(size_t)i * 1024];
        else if (i == 2048) v = 0.f;
        else v = raw[(size_t)(4096 - i) * 1024 + 256];
        tmp[i] = v; s += fabsf(v);
    }
    s = wave_sum(s);
    if ((tid & 63) == 0) red[tid >> 6] = s;
    __syncthreads();
    float tot = 0.f;
#pragma unroll
    for (int w = 0; w < 8; ++w) tot += red[w];
    const float inv = 1.0f / tot;
    for (int i = tid; i < 8 * 4096; i += 512) {
        const int q = i >> 12, x = i & 4095;
        const float v = tmp[(q - x) & 4095] * inv;
        *(LAS bf16_t*)(lds + q * HY_CP + x * 2) = (bf16_t)(pk2(v, 0.f) & 0xffffu);
    }
    __syncthreads();
}
template <int EPI>
__device__ __forceinline__ void hy_conv(const Args& a, int L, int c, const bf16_t* U, LAS unsigned char* lds) {
    const int tid = tidx(), wid = tid >> 6, lane = tid & 63, n = lane & 31, h = lane >> 5;
    const bf16_t* UC = (const bf16_t*)(a.ws + OFF_UC);
    bf16_t* Z = (bf16_t*)(a.ws + OFF_Z) + (size_t)c * MTOK;
    bf16_t* MIX = (bf16_t*)(a.ws + WS_MIX);
    const float dbias = a.in[18][L * 512 + EPI * 256 + c];
    const bf16_t* urow = U + (size_t)n * SEQ + 8 * h;
    LAS const unsigned char* fbase = lds + (n & 7) * HY_CP;
    const int foff = 8 * h - (n & ~7);
#pragma unroll 1
    for (int blk = 0; blk < 2; ++blk) {
        const int tb = 8 * wid + 4 * blk;
        f32x16 acc[4];
#pragma unroll
        for (int tt = 0; tt < 4; ++tt)
#pragma unroll
            for (int i = 0; i < 16; ++i) acc[tt][i] = 0.f;
        bf16x8 an[4];
#pragma unroll
        for (int k = 0; k < 4; ++k) an[k] = *(const bf16x8*)(urow + 16 * k);
#pragma unroll 1
        for (int s0 = 0; s0 < SEQ; s0 += 64) {
            bf16x8 ac[4];
#pragma unroll
            for (int k = 0; k < 4; ++k) ac[k] = an[k];
            if (s0 + 64 < SEQ) {
#pragma unroll
                for (int k = 0; k < 4; ++k) an[k] = *(const bf16x8*)(urow + s0 + 64 + 16 * k);
            }
            bf16x8 bfr[10];
            const int D0 = s0 - 32 * tb + foff;
#pragma unroll
            for (int d = 0; d < 10; ++d) { const int x = (D0 + 16 * (d - 6)) & 4095; bfr[d] = *(const LAS bf16x8*)(fbase + x * 2); }
#pragma unroll
            for (int k = 0; k < 4; ++k)
#pragma unroll
                for (int tt = 0; tt < 4; ++tt) acc[tt] = __builtin_amdgcn_mfma_f32_32x32x16_bf16(ac[k], bfr[k - 2 * tt + 6], acc[tt], 0, 0, 0);
        }
#pragma unroll
        for (int tt = 0; tt < 4; ++tt)
#pragma unroll
            for (int i = 0; i < 16; ++i) {
                const int bb = (i & 3) + 8 * (i >> 2) + 4 * h, t = 32 * (tb + tt) + n;
                const size_t tok = (size_t)bb * SEQ + t;
                if (EPI == 0) {
                    const float v = bf2f(UC[(size_t)c * MTOK + tok]), x1 = bf2f(UC[((size_t)256 + c) * MTOK + tok]);
                    const float z = x1 * (acc[tt][i] + dbias * v);
                    Z[tok] = (bf16_t)(pk2(z, 0.f) & 0xffffu);
                } else {
                    const float zz = bf2f(Z[tok]), x2 = bf2f(UC[((size_t)512 + c) * MTOK + tok]);
                    const float o = x2 * (acc[tt][i] + dbias * zz);
                    MIX[tok * DM + 384 + c] = (bf16_t)(pk2(o, 0.f) & 0xffffu);
                }
            }
    }
}
__device__ __forceinline__ void hyena_unit(const Args& a, int L, int c, LAS unsigned char* lds) {
    const int tid = tidx();
    const bf16_t* UT = (const bf16_t*)(a.ws + OFF_UT);
    bf16_t* UC = (bf16_t*)(a.ws + OFF_UC);
    const float* cwp = a.in[9] + L * 3 * 768; const float* cbp = a.in[10] + L * 768;
#pragma unroll 1
    for (int k3 = 0; k3 < 3; ++k3) {
        const int hc = 256 * k3 + c;
        const float w0 = cwp[hc], w1 = cwp[768 + hc], w2 = cwp[1536 + hc], bb = cbp[hc];
        const bf16_t* src = UT + (size_t)hc * MTOK; bf16_t* dst = UC + (size_t)hc * MTOK;
        for (int ck = tid; ck < MTOK / 8; ck += 512) {
            const int t0 = ck * 8, s = t0 & 2047;
            const u32x4 v = *(const u32x4*)(src + t0);
            float x[10];
            x[0] = (s == 0) ? 0.f : bf2f(src[t0 - 1]);
            x[1] = bflo(v.x); x[2] = bfhi(v.x); x[3] = bflo(v.y); x[4] = bfhi(v.y); x[5] = bflo(v.z); x[6] = bfhi(v.z); x[7] = bflo(v.w); x[8] = bfhi(v.w);
            x[9] = (s == 2040) ? 0.f : bf2f(src[t0 + 8]);
            float y[8];
#pragma unroll
            for (int j = 0; j < 8; ++j) y[j] = w0 * x[j] + w1 * x[j + 1] + w2 * x[j + 2] + bb;
            u32x4 o; o.x = pk2(y[0], y[1]); o.y = pk2(y[2], y[3]); o.z = pk2(y[4], y[5]); o.w = pk2(y[6], y[7]);
            *(u32x4*)(dst + t0) = o;
        }
    }
    __syncthreads();
    hy_filter(a, L, 0, c, lds);
    hy_conv<0>(a, L, c, UC + (size_t)c * MTOK, lds);
    __syncthreads();
    hy_filter(a, L, 1, c, lds);
    hy_conv<1>(a, L, c, (const bf16_t*)(a.ws + OFF_Z) + (size_t)c * MTOK, lds);
    __syncthreads();
}

__device__ __forceinline__ void row_pass(const bf16_t* F, const float* xold, float* xnew, const float* gpost, const float* gnext, bf16_t* H, int G, int c) {
    const int tid = tidx(), wid = tid >> 6; int lane = tid & 63; asm volatile("" : "+v"(lane));
    f32x4 gp[4], gn[4];
#pragma unroll
    for (int j = 0; j < 4; ++j) { gp[j] = *(const f32x4*)(gpost + 4 * lane + 256 * j); gn[j] = gnext ? *(const f32x4*)(gnext + 4 * lane + 256 * j) : (f32x4){0.f, 0.f, 0.f, 0.f}; }
    for (int rb = (c * 8 + wid) * 32; rb < MTOK; rb += G * 8 * 32) {
#pragma unroll 1
        for (int k = 0; k < 32; k += 4) {
            u32x2 fw[4][4]; f32x4 x[4][4];
#pragma unroll
            for (int u = 0; u < 4; ++u) {
                const size_t ro = (size_t)(rb + k + u) * DM + 4 * lane;
#pragma unroll
                for (int j = 0; j < 4; ++j) { fw[u][j] = *(const u32x2*)(F + ro + 256 * j); x[u][j] = *(const f32x4*)(xold + ro + 256 * j); }
            }
#pragma unroll
            for (int u = 0; u < 4; ++u) {
                const size_t ro = (size_t)(rb + k + u) * DM + 4 * lane;
                f32x4 f[4]; float s = 0.f;
#pragma unroll
                for (int j = 0; j < 4; ++j) { f[j] = (f32x4){bflo(fw[u][j].x), bfhi(fw[u][j].x), bflo(fw[u][j].y), bfhi(fw[u][j].y)}; s += (f[j][0] * f[j][0] + f[j][1] * f[j][1]) + (f[j][2] * f[j][2] + f[j][3] * f[j][3]); }
                const float rstd = rsqrtf(wave_sum(s) * (1.0f / DM) + EPS);
                float s2 = 0.f;
#pragma unroll
                for (int j = 0; j < 4; ++j) { x[u][j] = x[u][j] + f[j] * rstd * gp[j]; *(f32x4*)(xnew + ro + 256 * j) = x[u][j]; s2 += (x[u][j][0] * x[u][j][0] + x[u][j][1] * x[u][j][1]) + (x[u][j][2] * x[u][j][2] + x[u][j][3] * x[u][j][3]); }
                if (gnext) {
                    const float rstd2 = rsqrtf(wave_sum(s2) * (1.0f / DM) + EPS);
#pragma unroll
                    for (int j = 0; j < 4; ++j) { const f32x4 y = x[u][j] * rstd2 * gn[j]; u32x2 w; w.x = pk2(y[0], y[1]); w.y = pk2(y[2], y[3]); *(u32x2*)(H + ro + 256 * j) = w; }
                }
            }
        }
    }
}

__device__ __forceinline__ void ffn_fixup(const Args& a, int L, int panel) {
    const float* EP = (const float*)(a.ws + OFF_EP); const float* EG = (const float*)(a.ws + OFF_EG); const float* EU = (const float*)(a.ws + OFF_EU);
    bf16_t* ACT = (bf16_t*)(a.ws + WS_P);
    const float* cw = a.in[21] + (size_t)L * 3 * FF;
    int tid0 = tidx(); asm volatile("" : "+v"(tid0));
    for (int i = tid0; i < 8 * FF; i += 512) {
        const int e = i / FF, c = i % FF, gi = 4 * panel + (e >> 1), side = e & 1;
        const int row = 64 * gi + (side ? 63 : 0);
        const size_t eo = ((size_t)gi * 2 + side) * FF + c;
        float nb = 0.f, w;
        if (side == 0) { w = cw[c]; if ((row & 2047) != 0) nb = EG[((size_t)(gi - 1) * 2 + 1) * FF + c]; }
        else { w = cw[2 * FF + c]; if ((row & 2047) != 2047) nb = EG[((size_t)(gi + 1) * 2) * FF + c]; }
        const float pre = EP[eo] + w * nb;
        const float act = gelu_tanh(pre) * EU[eo];
        ACT[(size_t)row * FF + c] = (bf16_t)(pk2(act, 0.f) & 0xffffu);
    }
}

__device__ __forceinline__ void run_phase(const Args& a0, int ph, LAS unsigned char* lds) {
    Args a = a0;
#pragma unroll
    for (int i = 0; i < 24; ++i) { const __attribute__((address_space(1))) float* p = (const __attribute__((address_space(1))) float*)a0.in[i]; asm volatile("" : "+s"(p)); a.in[i] = (const float*)p; }
    { __attribute__((address_space(1))) float* p = (__attribute__((address_space(1))) float*)a0.out; asm volatile("" : "+s"(p)); a.out = (float*)p; }
    { __attribute__((address_space(1))) unsigned char* p = (__attribute__((address_space(1))) unsigned char*)a0.ws; asm volatile("" : "+s"(p)); a.ws = (unsigned char*)p; }
    int G = gridDim.x, c = blockIdx.x; asm volatile("" : "+s"(G), "+s"(c));
#ifndef PHM
#define PHM 63
#endif
    if (ph == 0) { for (int rep = 0; rep < NREP(32); ++rep) { phase0(a, lds); __syncthreads(); } return; }
    const int L = (ph - 1) / 7, sub = (ph - 1) % 7;
    bf16_t* H = (bf16_t*)(a.ws + WS_H);
    bf16_t* Fb = (bf16_t*)(a.ws + WS_F);
    if (sub == 0) {
        pg8::Gemm g{H, (const bf16_t*)(a.ws + WS_WIN) + (size_t)L * PW * DM, MTOK, PW, DM};
        pg8::StaticOrder S; S.init(MTOK, PW, G, c);
        EpiIn E{(bf16_t*)(a.ws + WS_P), (bf16_t*)(a.ws + OFF_UT), (const float*)(a.ws + WS_RAC), (const float*)(a.ws + WS_RAS), (const float*)(a.ws + WS_RCC), (const float*)(a.ws + WS_RCS),
                a.in[7] + L * 64, a.in[8] + L * 64, lds + 131072};
        for (int rep = 0; rep < NREP(8); ++rep) pg8::gemm_phase(lds, g, S, E);
    } else if (sub == 1) {
        for (int rep = 0; rep < NREP(1); ++rep) for (int ch = c; ch < 256; ch += G) hyena_unit(a, L, ch, lds);
        for (int rep = 0; rep < NREP(2); ++rep) for (int u = c; u < 768; u += G) attnC_unit(a, u, lds);
        for (int rep = 0; rep < NREP(4); ++rep) { __syncthreads(); for (int u = c; u < 768; u += G) { attnA_unit(a, u, lds); __syncthreads(); } }
    } else if (sub == 2) {
        pg8::Gemm g{(const bf16_t*)(a.ws + WS_MIX), (const bf16_t*)(a.ws + WS_WOUT) + (size_t)L * DM * DM, MTOK, DM, DM};
        pg8::StaticOrder S; S.init(MTOK, DM, G, c); EpiF E{Fb};
        for (int rep = 0; rep < NREP(64); ++rep) pg8::gemm_phase(lds, g, S, E);
    } else if (sub == 3) {
        row_pass(Fb, L == 0 ? a.in[0] : a.out, a.out, a.in[2] + L * DM, a.in[3] + L * DM, H, G, c);
    } else if (sub == 4) {
        pg8::Gemm g{H, (const bf16_t*)(a.ws + WS_WGU) + (size_t)L * 2 * FF * DM, MTOK, 2 * FF, DM};
        pg8::StaticOrder S; S.init(MTOK, 2 * FF, G, c);
        EpiGU E{(bf16_t*)(a.ws + WS_P), (float*)(a.ws + OFF_EP), (float*)(a.ws + OFF_EG), (float*)(a.ws + OFF_EU), a.in[21] + (size_t)L * 3 * FF, a.in[22] + (size_t)L * FF};
        for (int rep = 0; rep < NREP(16); ++rep) pg8::gemm_phase(lds, g, S, E);
    } else if (sub == 5) {
        pg8::Gemm g{(const bf16_t*)(a.ws + WS_P), (const bf16_t*)(a.ws + WS_WDN) + (size_t)L * DM * FF, MTOK, DM, FF};
        pg8::StaticOrder S; S.init(MTOK, DM, G, c); EpiF E{Fb};
        { Unit u; int last = -1; for (int i = 0; S.next(i, u); ++i) if (u.pm != last) { ffn_fixup(a, L, u.pm); last = u.pm; } }
        __syncthreads();
        pg8::gemm_phase(lds, g, S, E);
    } else {
        row_pass(Fb, a.out, a.out, a.in[4] + L * DM, L == 0 ? a.in[1] + DM : nullptr, H, G, c);
    }
}

#define XB_TMO      128
#define XB_XCNT(j)  (256  + 64 * (j))
#define XB_XSUB(j)  (1280 + 64 * (j))
#define XB_XGEN(j)  (2304 + 64 * (j))
#define XB_TOP      3328
#define XB_TOPGEN   3392
#define XB_SPIN_CAP (1u << 22)
__device__ __forceinline__ unsigned xb_ld(unsigned* p)              { return __hip_atomic_load(p, __ATOMIC_RELAXED, __HIP_MEMORY_SCOPE_AGENT); }
__device__ __forceinline__ unsigned xb_add(unsigned* p, unsigned v) { return __hip_atomic_fetch_add(p, v, __ATOMIC_RELAXED, __HIP_MEMORY_SCOPE_AGENT); }
__device__ __forceinline__ unsigned xb_xcc_id() { return (unsigned)__builtin_amdgcn_s_getreg((3 << 11) | 20) & 0xFu; }
#define XB_SPIN(cond, bar) do { unsigned _sp = 0; while (cond) { __builtin_amdgcn_s_sleep(1); \
    if ((++_sp & 255u) == 0u) { if (xb_ld(&(bar)[XB_TMO])) break; if (_sp > XB_SPIN_CAP) { atomicAdd(&(bar)[XB_TMO], 1u); break; } } } } while (0)
struct XbCensus { unsigned nloc, nx; };
__device__ __forceinline__ XbCensus xcd_barrier_complete(unsigned* bar, unsigned x) {
    const unsigned G = gridDim.x;
    unsigned sum, cnt, mine, sp = 0u;
    for (;;) {
        sum = 0u; cnt = 0u; mine = 0u;
#pragma unroll
        for (unsigned j = 0; j < 16; ++j) { const unsigned c = xb_ld(&bar[XB_XCNT(j)]); sum += c; cnt += (c > 0u) ? 1u : 0u; mine = (j == x) ? c : mine; }
        if (sum == G) break;
        __builtin_amdgcn_s_sleep(1);
        if ((++sp & 255u) == 0u) { if (xb_ld(&bar[XB_TMO])) break; if (sp > XB_SPIN_CAP) { atomicAdd(&bar[XB_TMO], 1u); break; } }
    }
    XbCensus r; r.nloc = mine > 0u ? mine : 1u; r.nx = cnt > 0u ? cnt : 1u; return r;
}
__device__ __forceinline__ void xcd_barrier(unsigned* bar, unsigned x, bool first) {
    asm volatile("s_waitcnt vmcnt(0)" ::: "memory");
    __syncthreads();
    if (threadIdx.x == 0) {
        __builtin_amdgcn_s_waitcnt(0);
        unsigned* slot = bar + 4096 + 2 * blockIdx.x;
        XbCensus cs;
        if (first) { cs = xcd_barrier_complete(bar, x); slot[0] = cs.nloc; slot[1] = cs.nx; }
        else { cs.nloc = xb_ld(slot); cs.nx = xb_ld(slot + 1); }
        const unsigned nloc = cs.nloc, nx = cs.nx;
        const unsigned old = xb_add(&bar[XB_XSUB(x)], 1u);
        const unsigned gen = old / nloc;
        if (old + 1u == (gen + 1u) * nloc) {
            __builtin_amdgcn_fence(__ATOMIC_RELEASE, "agent");
            asm volatile("s_waitcnt vmcnt(0)" ::: "memory");
            const unsigned og = xb_add(&bar[XB_TOP], 1u);
            const unsigned tg = og / nx;
            if (og + 1u == (tg + 1u) * nx) xb_add(&bar[XB_TOPGEN], 1u);
            else XB_SPIN(xb_ld(&bar[XB_TOPGEN]) == tg, bar);
            __builtin_amdgcn_fence(__ATOMIC_ACQUIRE, "agent");
            xb_add(&bar[XB_XGEN(x)], 1u);
            asm volatile("s_waitcnt vmcnt(0)" ::: "memory");
        } else {
            XB_SPIN(xb_ld(&bar[XB_XGEN(x)]) == gen, bar);
            __builtin_amdgcn_fence(__ATOMIC_ACQUIRE, "agent");
            asm volatile("s_waitcnt vmcnt(0)" ::: "memory");
        }
    }
    __syncthreads();
}

__global__ __launch_bounds__(512, 2) void mk_fwd(Args a) {
    extern __shared__ __attribute__((aligned(16))) unsigned char lds_raw[];
    LAS unsigned char* lds = (LAS unsigned char*)lds_raw;
    unsigned* bar = (unsigned*)a.ws;
    unsigned xcc = 0u;
    if (a.coop) { xcc = xb_xcc_id(); if (threadIdx.x == 0) (void)xb_add(&bar[XB_XCNT(xcc)], 1u); }
    (void)xcc;
    for (int ph = a.ph_lo; ph < a.ph_hi; ++ph) {
        run_phase(a, ph, lds);
        if (a.coop && ph + 1 < a.ph_hi) {
            if (ph == 0) cg::this_grid().sync();
            else xcd_barrier(bar, xb_xcc_id(), ph == 1);
        }
    }
}

extern "C" void kernel_launch(void* const* d_in, const int* in_sizes, int n_in, void* d_out, int out_size, void* d_ws, size_t ws_size, hipStream_t stream) {
    static int grid = 0;
    if (grid == 0) {
        if (n_in != 24 || out_size != MTOK * DM || ws_size < WS_END) { fprintf(stderr, "kernel_launch: unexpected shapes / workspace (n_in %d out %d ws %zu need %zu)\n", n_in, out_size, ws_size, (size_t)WS_END); grid = -1; return; }
        int dev = 0, cus = 0, per_cu = 0;
        hipGetDevice(&dev); hipDeviceGetAttribute(&cus, hipDeviceAttributeMultiprocessorCount, dev);
        if (hipFuncSetAttribute((const void*)mk_fwd, hipFuncAttributeMaxDynamicSharedMemorySize, LDS_BYTES) != hipSuccess) { fprintf(stderr, "kernel_launch: hipFuncSetAttribute failed\n"); grid = -1; return; }
        if (hipOccupancyMaxActiveBlocksPerMultiprocessor(&per_cu, (const void*)mk_fwd, 512, LDS_BYTES) != hipSuccess || per_cu < 1) { fprintf(stderr, "kernel_launch: occupancy query says %d\n", per_cu); per_cu = 1; }
        (void)hipGetLastError();
        grid = cus;
    }
    if (grid < 0) return;
    if (hipMemsetAsync(d_ws, 0, 32768, stream) != hipSuccess) { fprintf(stderr, "kernel_launch: memset of the barrier words failed\n"); return; }
    Args a{};
    for (int i = 0; i < 24; ++i) a.in[i] = (const float*)d_in[i];
    a.out = (float*)d_out; a.ws = (unsigned char*)d_ws;
#if MK_COOP
    a.ph_lo = 0; a.ph_hi = NPH; a.coop = 1;
    void* args[] = {&a};
    hipError_t e = hipLaunchCooperativeKernel((const void*)mk_fwd, dim3(grid), dim3(512), args, LDS_BYTES, stream);
    if (e != hipSuccess) fprintf(stderr, "cooperative launch failed: %s (grid %d)\n", hipGetErrorString(e), grid);
#else
    for (int ph = 0; ph < NPH; ++ph) {
        a.ph_lo = ph; a.ph_hi = ph + 1; a.coop = 0;
        hipLaunchKernelGGL(mk_fwd, dim3(grid), dim3(512), LDS_BYTES, stream, a);
    }
#endif
}
```

```cpp
#include <hip/hip_runtime.h>
#include <hip/hip_cooperative_groups.h>
#include <cstdio>
namespace cg = cooperative_groups;

#ifndef NPH
#define NPH 15
#endif
#ifndef REPM
#define REPM 0
#endif
#define NREP(bit) ((REPM & (bit)) ? 2 : 1)
#ifndef MK_COOP
#define MK_COOP 1
#endif

#define LAS __attribute__((address_space(3)))
typedef unsigned short bf16_t;
typedef short bf16x8 __attribute__((ext_vector_type(8)));
typedef short bf16x4 __attribute__((ext_vector_type(4)));
typedef float f32x4 __attribute__((ext_vector_type(4)));
typedef float f32x16 __attribute__((ext_vector_type(16)));
typedef unsigned u32x4 __attribute__((ext_vector_type(4)));
typedef unsigned u32x2 __attribute__((ext_vector_type(2)));

constexpr int NB = 32, SEQ = 2048, DM = 1024, MTOK = NB * SEQ, PW = 2560, FF = 2816;
constexpr int CQ0 = 1920, CK0 = 2304, CV0 = 2432;
constexpr float LOG2E = 1.4426950408889634f;
constexpr float EPS = 1e-6f;

constexpr size_t WS_RAC = 32768;
constexpr size_t WS_RAS = WS_RAC + 2048 * 32 * 4;
constexpr size_t WS_RCC = WS_RAS + 2048 * 32 * 4;
constexpr size_t WS_RCS = WS_RCC + 64 * 16 * 4;
constexpr size_t WS_WIN = WS_RCS + 64 * 16 * 4;
constexpr size_t WS_WOUT = WS_WIN + 2ull * 2560 * 1024 * 2;
constexpr size_t WS_WGU = WS_WOUT + 2ull * 1024 * 1024 * 2;
constexpr size_t WS_WDN = WS_WGU + 2ull * 5632 * 1024 * 2;
constexpr size_t WS_HRAW = WS_WDN + 2ull * 1024 * 2816 * 2;
constexpr size_t WS_H = WS_HRAW + 2ull * 2048 * 1024 * 4;
constexpr size_t WS_P = WS_H + (size_t)MTOK * 1024 * 2;
constexpr size_t WS_MIX = WS_P + (size_t)MTOK * 2816 * 2;
constexpr size_t WS_F = WS_MIX + (size_t)MTOK * 1024 * 2;
constexpr size_t WS_END = WS_F + (size_t)MTOK * 1024 * 4;
constexpr size_t OFF_UC = WS_H, OFF_Z = WS_H + 3ull * 256 * MTOK * 2;
constexpr size_t OFF_UT = WS_F, OFF_OA = WS_F + 768ull * MTOK * 2, OFF_LSE = OFF_OA + 2ull * MTOK * 384 * 2;
constexpr size_t EDGE_SZ = 1024ull * 2 * FF * 4;
constexpr size_t OFF_EP = WS_MIX, OFF_EG = WS_MIX + EDGE_SZ, OFF_EU = WS_MIX + 2 * EDGE_SZ;
constexpr int LDS_BYTES = 163840;

struct Args { const float* in[24]; float* out; unsigned char* ws; int ph_lo, ph_hi, coop, pad; };

__device__ __forceinline__ int tidx() { int t = threadIdx.x; asm volatile("" : "+v"(t)); return t; }
__device__ __forceinline__ unsigned pk2(float lo, float hi) { unsigned r; asm("v_cvt_pk_bf16_f32 %0, %1, %2" : "=v"(r) : "v"(lo), "v"(hi)); return r; }
typedef float f32x2v __attribute__((ext_vector_type(2)));
typedef __bf16 bf16v2 __attribute__((ext_vector_type(2)));
__device__ __forceinline__ unsigned pk2n(float lo, float hi) { const f32x2v v = {lo, hi}; const bf16v2 b = __builtin_convertvector(v, bf16v2); return __builtin_bit_cast(unsigned, b); }
__device__ __forceinline__ float bf2f(bf16_t b) { return __uint_as_float(((unsigned)b) << 16); }
__device__ __forceinline__ float bflo(unsigned w) { return __uint_as_float(w << 16); }
__device__ __forceinline__ float bfhi(unsigned w) { return __uint_as_float(w & 0xffff0000u); }
__device__ __forceinline__ float wave_sum(float v) {
#pragma unroll
    for (int o = 1; o < 64; o <<= 1) v += __shfl_xor(v, o);
    return v;
}
__device__ __forceinline__ float fexp2(float x) { return __builtin_amdgcn_exp2f(x); }
__device__ __forceinline__ float gelu_tanh_mul(float x, float up) {
    constexpr float C1 = -2.0f * 0.7978845608028654f * LOG2E, C3 = C1 * 0.044715f;
    const float p = __builtin_fmaf(x * x, C3, C1);
    const float e = fexp2(x * p);
    return (x * up) * __builtin_amdgcn_rcpf(1.0f + e);
}
__device__ __forceinline__ float gelu_tanh(float x) {
    const float u = x * (1.0f + 0.044715f * x * x);
    const float e = fexp2(-2.0f * 0.7978845608028654f * LOG2E * u);
    return x * __builtin_amdgcn_rcpf(1.0f + e);
}

namespace pg8 {
constexpr int BM = 256, BK = 64, HALF = 128, HTB = HALF * BK * 2, STAGE_BYTES = 8 * HTB, NXCD = 8, WGM = 8;
__device__ __forceinline__ int lds_byte(int r, int c) { const int st = (r >> 4) * 2 + (c >> 5), rr = r & 15, cc = c & 31, ob = rr * 64 + cc * 2; return st * 1024 + (ob ^ (((ob >> 9) & 1) << 5)); }
__device__ __forceinline__ void stage_rc(int b, int& R, int& C) { const int st = b / 1024, sb = b % 1024, swz = sb ^ (((sb >> 9) & 1) << 5); R = (st >> 1) * 16 + swz / 64; C = (st & 1) * 32 + (swz % 64) / 2; }
struct Unit { int pm, pn; };
struct Gemm { const bf16_t* A; const bf16_t* Bt; int M, N, K; };
struct StaticOrder {
    int nM, nN, nwg, G, c;
    __device__ void init(int M, int N, int G_, int c_) { nM = M / BM; nN = N / BM; nwg = nM * nN; G = G_; c = c_; }
    __device__ __forceinline__ bool next(int i, Unit& u) const {
        const long L = (long)i * G + c; if (L >= nwg) return false;
        int wgid = (int)L; { const int q = nwg / NXCD, r = nwg % NXCD, xcd = wgid % NXCD, off = wgid / NXCD; wgid = (xcd < r ? xcd * (q + 1) : r * (q + 1) + (xcd - r) * q) + off; }
        const int nig = WGM * nN, gid = wgid / nig, fm = gid * WGM, gsz = (nM - fm) < WGM ? (nM - fm) : WGM;
        u.pm = fm + ((wgid % nig) % gsz); u.pn = (wgid % nig) / gsz; return true;
    }
};
struct PanelOrder {
    int pm;
    __device__ __forceinline__ bool next(int i, Unit& u) const { if (i >= 4) return false; u.pm = pm; u.pn = i; return true; }
};

template <class Epi, class Sched>
__device__ __forceinline__ void gemm_phase(LAS unsigned char* lds, const Gemm g, const Sched& S, const Epi& E) {
    const int tid = tidx(), wid = __builtin_amdgcn_readfirstlane(tid >> 6), lane = tid & 63, wr = wid >> 2, wc = wid & 3, fr = lane & 15, fq = lane >> 4;
    const int K = g.K, nt = K / BK;
    unsigned voffA[2], voffB[2];
#pragma unroll
    for (int i = 0; i < 2; ++i) { int R, C; stage_rc(tid * 16 + i * 8192, R, C); voffA[i] = (unsigned)(R * K + C) * 2u; voffB[i] = voffA[i]; }
    const size_t kstep = (size_t)(BK * 2);
    const size_t hstep = (size_t)HALF * K * 2;
    const size_t tstep = 2 * hstep;
    const unsigned ldsw = (unsigned)wid * 1024u;
    const int aoff = lds_byte(wr * 64 + fr, fq * 8), boff = lds_byte(wc * 32 + fr, fq * 8);
#define PG8_SA(b, h) (((b) * 2 + (h)) * HTB)
#define PG8_SB(b, h) ((4 + (b) * 2 + (h)) * HTB)
#define PG8_STAGE(bufoff, gbase, voff) do { _Pragma("unroll") for (int _i = 0; _i < 2; ++_i) \
        __builtin_amdgcn_global_load_lds((const unsigned*)((const char*)(gbase) + (voff)[_i]), (LAS unsigned*)(lds + (bufoff) + ldsw + _i * 8192), 16, 0, 0); } while (0)
#define PG8_LDA(dst, b, h) do { _Pragma("unroll") for (int m = 0; m < 4; ++m) _Pragma("unroll") for (int k = 0; k < 2; ++k) dst[m][k] = *(const LAS bf16x8*)(lds + PG8_SA(b, h) + aoff + m * 2048 + k * 1024); } while (0)
#define PG8_LDB(dst, b, h) do { _Pragma("unroll") for (int n = 0; n < 2; ++n) _Pragma("unroll") for (int k = 0; k < 2; ++k) dst[n][k] = *(const LAS bf16x8*)(lds + PG8_SB(b, h) + boff + n * 2048 + k * 1024); } while (0)
#define PG8_MMA(ai, bj, At, Bt) do { __builtin_amdgcn_s_setprio(1); _Pragma("unroll") for (int m = 0; m < 4; ++m) _Pragma("unroll") for (int n = 0; n < 2; ++n) _Pragma("unroll") for (int k = 0; k < 2; ++k) \
        acc[ai][bj][m][n] = __builtin_amdgcn_mfma_f32_16x16x32_bf16(Bt[n][k], At[m][k], acc[ai][bj][m][n], 0, 0, 0); __builtin_amdgcn_s_setprio(0); } while (0)
#define PG8_WAIT_V(n) asm volatile("s_waitcnt vmcnt(" #n ")" ::: "memory")
#define PG8_WAIT_L(n) asm volatile("s_waitcnt lgkmcnt(" #n ")" ::: "memory")
#define PG8_BAR __builtin_amdgcn_s_barrier()
#define PG8_SCHED __builtin_amdgcn_sched_barrier(0)
    Unit cur, nxt; int ui = 0;
    if (!S.next(0, cur)) return;
    f32x4 acc[2][2][4][2];
#pragma unroll
    for (int a = 0; a < 2; ++a)
#pragma unroll
        for (int b = 0; b < 2; ++b)
#pragma unroll
            for (int m = 0; m < 4; ++m)
#pragma unroll
                for (int n = 0; n < 2; ++n) acc[a][b][m][n] = (f32x4){0.f, 0.f, 0.f, 0.f};
    bf16x8 At[4][2], B0[2][2], B1[2][2];
    const char* cA = (const char*)g.A + (size_t)cur.pm * tstep; const char* cB = (const char*)g.Bt + (size_t)cur.pn * tstep;
    PG8_STAGE(PG8_SB(0, 0), cB, voffB); PG8_STAGE(PG8_SA(0, 0), cA, voffA); PG8_STAGE(PG8_SB(0, 1), cB + hstep, voffB); PG8_STAGE(PG8_SA(0, 1), cA + hstep, voffA);
    if (wr == 1) PG8_BAR;
    PG8_WAIT_V(4); PG8_BAR;
    PG8_STAGE(PG8_SB(1, 0), cB + kstep, voffB); PG8_STAGE(PG8_SA(1, 0), cA + kstep, voffA); PG8_STAGE(PG8_SB(1, 1), cB + hstep + kstep, voffB);
    PG8_WAIT_V(6); PG8_BAR;
    for (;;) {
        const bool has_next = S.next(ui + 1, nxt);
        const char* nA = has_next ? (const char*)g.A + (size_t)nxt.pm * tstep : cA; const char* nB = has_next ? (const char*)g.Bt + (size_t)nxt.pn * tstep : cB;
        for (int t = 0; t < nt; t += 2) {
            const bool last = (t == nt - 2);
            const char* a1 = cA + (size_t)(t + 1) * kstep;
            const char* a2 = last ? nA : cA + (size_t)(t + 2) * kstep; const char* b2 = last ? nB : cB + (size_t)(t + 2) * kstep;
            const char* a3 = a2 + kstep; const char* b3 = b2 + kstep;
            PG8_LDB(B0, 0, 0); PG8_SCHED; PG8_LDA(At, 0, 0); PG8_STAGE(PG8_SA(1, 1), a1 + hstep, voffA);
            PG8_WAIT_L(8); PG8_BAR; PG8_WAIT_L(0); PG8_MMA(0, 0, At, B0); PG8_BAR; PG8_SCHED;
            PG8_LDB(B1, 0, 1); PG8_STAGE(PG8_SB(0, 0), b2, voffB);
            PG8_BAR; PG8_WAIT_L(0); PG8_MMA(0, 1, At, B1); PG8_BAR;
            PG8_LDA(At, 0, 1); PG8_STAGE(PG8_SA(0, 0), a2, voffA);
            PG8_BAR; PG8_WAIT_L(0); PG8_MMA(1, 0, At, B0); PG8_BAR; PG8_SCHED;
            PG8_STAGE(PG8_SB(0, 1), b2 + hstep, voffB);
            PG8_WAIT_V(6); PG8_BAR; PG8_MMA(1, 1, At, B1); PG8_BAR;
            PG8_LDB(B0, 1, 0); PG8_SCHED; PG8_LDA(At, 1, 0); PG8_STAGE(PG8_SA(0, 1), a2 + hstep, voffA);
            PG8_WAIT_L(8); PG8_BAR; PG8_WAIT_L(0); PG8_MMA(0, 0, At, B0); PG8_BAR; PG8_SCHED;
            PG8_LDB(B1, 1, 1); PG8_STAGE(PG8_SB(1, 0), b3, voffB);
            PG8_BAR; PG8_WAIT_L(0); PG8_MMA(0, 1, At, B1); PG8_BAR;
            PG8_LDA(At, 1, 1); PG8_STAGE(PG8_SA(1, 0), a3, voffA);
            PG8_BAR; PG8_WAIT_L(0); PG8_MMA(1, 0, At, B0); PG8_BAR; PG8_SCHED;
            PG8_STAGE(PG8_SB(1, 1), b3 + hstep, voffB);
            PG8_WAIT_V(6); PG8_BAR; PG8_MMA(1, 1, At, B1); PG8_BAR;
        }
        E(acc, cur, wr, wc, fr, fq);
        if (!has_next) break;
#pragma unroll
        for (int a = 0; a < 2; ++a)
#pragma unroll
            for (int b = 0; b < 2; ++b)
#pragma unroll
                for (int m = 0; m < 4; ++m)
#pragma unroll
                    for (int n = 0; n < 2; ++n) acc[a][b][m][n] = (f32x4){0.f, 0.f, 0.f, 0.f};
        cur = nxt; cA = nA; cB = nB; ++ui;
    }
    PG8_WAIT_V(0);
    if (wr == 0) PG8_BAR;
    PG8_BAR;
#undef PG8_SA
#undef PG8_SB
#undef PG8_STAGE
#undef PG8_LDA
#undef PG8_LDB
#undef PG8_MMA
#undef PG8_WAIT_V
#undef PG8_WAIT_L
#undef PG8_BAR
#undef PG8_SCHED
}
}
using pg8::Unit;

struct EpiIn {
    bf16_t* P; bf16_t* UT; const float* rac; const float* ras; const float* rcc; const float* rcs; const float* gq; const float* gk; LAS unsigned char* scr;
    __device__ __forceinline__ void operator()(const f32x4 (&acc)[2][2][4][2], const Unit& uu, int wr, int wc, int fr, int fq) const {
        Unit u = uu; asm volatile("" : "+s"(u.pm), "+s"(u.pn), "+v"(fr), "+v"(fq));
        const int ch = 4 * u.pn + wc;
        const int rowb = u.pm * 256 + wr * 64 + fr;
        if (ch < 12) {
            const float qs = (ch < 6) ? 0.125f * LOG2E : 1.0f;
#pragma unroll
            for (int ai = 0; ai < 2; ++ai)
#pragma unroll
                for (int m = 0; m < 4; ++m) {
                    const int r = rowb + 128 * ai + 16 * m, s = r & 2047;
                    u32x4 w1, w2;
                    {
                        const f32x4 c0 = *(const f32x4*)(rac + s * 32 + 8 * fq), s0 = *(const f32x4*)(ras + s * 32 + 8 * fq);
                        const f32x4 c1 = *(const f32x4*)(rac + s * 32 + 8 * fq + 4), s1 = *(const f32x4*)(ras + s * 32 + 8 * fq + 4);
                        const f32x4 x10 = acc[ai][0][m][0], x11 = acc[ai][0][m][1], x20 = acc[ai][1][m][0], x21 = acc[ai][1][m][1];
                        const f32x4 a0 = (x10 * c0 - x20 * s0) * qs, a1 = (x11 * c1 - x21 * s1) * qs;
                        const f32x4 b0 = (x20 * c0 + x10 * s0) * qs, b1 = (x21 * c1 + x11 * s1) * qs;
                        w1.x = pk2(a0[0], a0[1]); w1.y = pk2(a0[2], a0[3]); w1.z = pk2(a1[0], a1[1]); w1.w = pk2(a1[2], a1[3]);
                        w2.x = pk2(b0[0], b0[1]); w2.y = pk2(b0[2], b0[3]); w2.z = pk2(b1[0], b1[1]); w2.w = pk2(b1[2], b1[3]);
                    }
                    bf16_t* dst = P + (size_t)r * PW + 64 * ch + 8 * fq;
                    *(u32x4*)dst = w1; *(u32x4*)(dst + 32) = w2;
                }
        } else if (ch < 18 || ch >= 38) {
#pragma unroll
            for (int ai = 0; ai < 2; ++ai)
#pragma unroll
                for (int m = 0; m < 4; ++m) {
                    const int r = rowb + 128 * ai + 16 * m;
                    bf16_t* dst = P + (size_t)r * PW + 64 * ch + 8 * fq;
#pragma unroll
                    for (int bj = 0; bj < 2; ++bj) {
                        const f32x4 v0 = acc[ai][bj][m][0], v1 = acc[ai][bj][m][1];
                        u32x4 w; w.x = pk2(v0[0], v0[1]); w.y = pk2(v0[2], v0[3]); w.z = pk2(v1[0], v1[1]); w.w = pk2(v1[2], v1[3]);
                        *(u32x4*)(dst + 32 * bj) = w;
                    }
                }
        } else if (ch < 30) {
            const int wid = wr * 4 + wc, lane = fq * 16 + fr;
            LAS unsigned char* T = scr + wid * 4096;
#pragma unroll
            for (int ai = 0; ai < 2; ++ai)
#pragma unroll
                for (int bj = 0; bj < 2; ++bj) {
#pragma unroll
                    for (int m = 0; m < 4; ++m)
#pragma unroll
                        for (int n = 0; n < 2; ++n)
#pragma unroll
                            for (int j = 0; j < 4; ++j) {
                                const int chl = 8 * fq + 4 * n + j, rl = 16 * m + fr;
                                *(LAS bf16_t*)(T + chl * 128 + rl * 2) = (bf16_t)(pk2(acc[ai][bj][m][n][j], 0.f) & 0xffffu);
                            }
                    asm volatile("s_waitcnt lgkmcnt(0)" ::: "memory");
                    const int r0 = u.pm * 256 + 128 * ai + 64 * wr;
                    const int hc0 = 64 * (ch - 18) + 32 * bj;
#pragma unroll
                    for (int q = 0; q < 4; ++q) {
                        const int idx = q * 64 + lane, chl = idx >> 3, k = idx & 7;
                        const u32x4 v = *(const LAS u32x4*)(T + chl * 128 + k * 16);
                        *(u32x4*)(UT + (size_t)(hc0 + chl) * MTOK + r0 + 8 * k) = v;
                    }
                    asm volatile("s_waitcnt lgkmcnt(0)" ::: "memory");
                }
        } else {
            const float* g = (ch < 36) ? gq : gk;
            const float qs = (ch < 36) ? 0.125f * LOG2E : 1.0f;
            f32x4 g4[2][2];
#pragma unroll
            for (int bj = 0; bj < 2; ++bj)
#pragma unroll
                for (int n = 0; n < 2; ++n) g4[bj][n] = *(const f32x4*)(g + 32 * bj + 16 * n + 4 * fq);
#pragma unroll
            for (int ai = 0; ai < 2; ++ai)
#pragma unroll
                for (int m = 0; m < 4; ++m) {
                    const int r = rowb + 128 * ai + 16 * m, s = r & 2047;
                    float ss = 0.f;
#pragma unroll
                    for (int bj = 0; bj < 2; ++bj)
#pragma unroll
                        for (int n = 0; n < 2; ++n) { const f32x4 x = acc[ai][bj][m][n]; ss += (x[0] * x[0] + x[1] * x[1]) + (x[2] * x[2] + x[3] * x[3]); }
                    ss += __shfl_xor(ss, 16); ss += __shfl_xor(ss, 32);
                    const float rstd = rsqrtf(ss * (1.0f / 64.0f) + EPS) * qs;
                    bf16_t* dst = P + (size_t)r * PW + 64 * ch + 8 * fq;
#pragma unroll
                    for (int bj = 0; bj < 2; ++bj) {
                        const int pos = bj ? (s & 63) : (s >> 6);
                        const f32x4 c = *(const f32x4*)(rcc + pos * 16 + 4 * fq), sn = *(const f32x4*)(rcs + pos * 16 + 4 * fq);
                        const f32x4 x1 = acc[ai][bj][m][0] * g4[bj][0] * rstd, x2 = acc[ai][bj][m][1] * g4[bj][1] * rstd;
                        const f32x4 o1 = x1 * c - x2 * sn, o2 = x2 * c + x1 * sn;
                        u32x4 w; w.x = pk2(o1[0], o1[1]); w.y = pk2(o1[2], o1[3]); w.z = pk2(o2[0], o2[1]); w.w = pk2(o2[2], o2[3]);
                        *(u32x4*)(dst + 32 * bj) = w;
                    }
                }
        }
    }
};

struct EpiF {
    bf16_t* F;
    __device__ __forceinline__ void operator()(const f32x4 (&acc)[2][2][4][2], const Unit& uu, int wr, int wc, int fr, int fq) const {
        Unit u = uu; asm volatile("" : "+s"(u.pm), "+s"(u.pn), "+v"(fr), "+v"(fq));
        const int row0 = u.pm * 256 + wr * 64 + fr, col0 = u.pn * 256 + wc * 32 + 8 * fq;
#pragma unroll
        for (int ai = 0; ai < 2; ++ai)
#pragma unroll
            for (int m = 0; m < 4; ++m) {
                bf16_t* rowp = F + (size_t)(row0 + ai * 128 + m * 16) * DM + col0;
#pragma unroll
                for (int bj = 0; bj < 2; ++bj) {
                    const f32x4 v0 = acc[ai][bj][m][0], v1 = acc[ai][bj][m][1];
                    u32x4 w; w.x = pk2(v0[0], v0[1]); w.y = pk2(v0[2], v0[3]); w.z = pk2(v1[0], v1[1]); w.w = pk2(v1[2], v1[3]);
                    *(u32x4*)(rowp + bj * 128) = w;
                }
            }
    }
};

struct EpiGU {
    bf16_t* ACT; float* EP; float* EG; float* EU; const float* cw; const float* cb;
    __device__ __forceinline__ void operator()(const f32x4 (&acc)[2][2][4][2], const Unit& uu, int wr, int wc, int fr, int fq) const {
        Unit u = uu; asm volatile("" : "+s"(u.pm), "+s"(u.pn), "+v"(fr), "+v"(fq));
        const int chan0 = 128 * u.pn + 32 * wc + 8 * fq;
        const int lane = fq * 16 + fr;
        const int srcU = (lane & 48) | ((fr + 15) & 15), srcD = (lane & 48) | ((fr + 1) & 15);
#pragma unroll
        for (int ai = 0; ai < 2; ++ai) {
            const int Rg = u.pm * 256 + 128 * ai + 64 * wr;
            const int gi = Rg >> 6;
#pragma unroll
            for (int n = 0; n < 2; ++n) {
                const f32x4 w0 = *(const f32x4*)(cw + chan0 + 4 * n), w1 = *(const f32x4*)(cw + FF + chan0 + 4 * n), w2 = *(const f32x4*)(cw + 2 * FF + chan0 + 4 * n), bb = *(const f32x4*)(cb + chan0 + 4 * n);
                f32x4 av[4], ptop, pbot;
#pragma unroll
                for (int j = 0; j < 4; ++j) {
                    float gv[4], ru[4], rd[4];
#pragma unroll
                    for (int m = 0; m < 4; ++m) { gv[m] = acc[ai][0][m][n][j];
                        ru[m] = __int_as_float(__builtin_amdgcn_update_dpp(0, __float_as_int(gv[m]), 0x121, 0xf, 0xf, false));
                        rd[m] = __int_as_float(__builtin_amdgcn_update_dpp(0, __float_as_int(gv[m]), 0x12f, 0xf, 0xf, false)); }
#pragma unroll
                    for (int m = 0; m < 4; ++m) {
                        const float prev = (fr == 0) ? (m > 0 ? ru[m > 0 ? m - 1 : 0] : 0.f) : ru[m];
                        const float next = (fr == 15) ? (m < 3 ? rd[m < 3 ? m + 1 : 3] : 0.f) : rd[m];
                        const float pre = w0[j] * prev + w1[j] * gv[m] + w2[j] * next + bb[j];
                        av[m][j] = gelu_tanh_mul(pre, acc[ai][1][m][n][j]);
                        if (m == 0) ptop[j] = pre;
                        if (m == 3) pbot[j] = pre;
                    }
                }
                if (fr == 0) { const size_t eo = ((size_t)gi * 2) * FF + chan0 + 4 * n; *(f32x4*)(EP + eo) = ptop; *(f32x4*)(EG + eo) = acc[ai][0][0][n]; *(f32x4*)(EU + eo) = acc[ai][1][0][n]; }
                if (fr == 15) { const size_t eo = ((size_t)gi * 2 + 1) * FF + chan0 + 4 * n; *(f32x4*)(EP + eo) = pbot; *(f32x4*)(EG + eo) = acc[ai][0][3][n]; *(f32x4*)(EU + eo) = acc[ai][1][3][n]; }
#pragma unroll
                for (int m = 0; m < 4; ++m) {
                    const bool edge = ((m == 0) && (fr == 0)) || ((m == 3) && (fr == 15));
                    if (!edge) { u32x2 w; w.x = pk2(av[m][0], av[m][1]); w.y = pk2(av[m][2], av[m][3]); *(u32x2*)(ACT + (size_t)(Rg + 16 * m + fr) * FF + chan0 + 4 * n) = w; }
                }
            }
        }
    }
};

__device__ __forceinline__ int colmap_in(int R) {
    const int T = R >> 8, rt = R & 255, bj = rt >> 7, wc = (rt >> 5) & 3, n = (rt >> 4) & 1, fq = (rt >> 2) & 3, j = rt & 3;
    const int ch = 4 * T + wc;
    const int l = (ch >= 30 && ch < 38) ? (32 * bj + 16 * n + 4 * fq + j) : (32 * bj + 8 * fq + 4 * n + j);
    return 64 * ch + l;
}
template <int MODE>
__device__ __forceinline__ void transpose_item(const Args& a, int layer, int item, LAS float* scr, int lane) {
    constexpr int K = (MODE == 3) ? FF : DM;
    constexpr int NP = (MODE == 0) ? PW : (MODE == 2 ? 2 * FF : DM);
    constexpr int N = (MODE == 0) ? PW : (MODE == 2 ? FF : DM);
    const int nblk = NP / 32, kb = item / nblk, nb = item % nblk, k0 = 64 * kb, n0 = 32 * nb;
    const int R = n0 + (lane & 31);
    const float* src; int col;
    if (MODE == 0) { src = a.in[5] + (size_t)layer * DM * PW; col = colmap_in(R); }
    else if (MODE == 1) { src = a.in[6] + (size_t)layer * DM * DM; col = (R & ~31) + 8 * ((R >> 2) & 3) + 4 * ((R >> 4) & 1) + (R & 3); }
    else if (MODE == 2) {
        const int T = R >> 8, rt = R & 255, bj = rt >> 7, wc = (rt >> 5) & 3, n = (rt >> 4) & 1, fq = (rt >> 2) & 3, j = rt & 3;
        col = 128 * T + 32 * wc + 8 * fq + 4 * n + j; src = (bj ? a.in[20] : a.in[19]) + (size_t)layer * DM * FF;
    } else { src = a.in[23] + (size_t)layer * FF * DM; col = (R & ~31) + 8 * ((R >> 2) & 3) + 4 * ((R >> 4) & 1) + (R & 3); }
    bf16_t* WT = (bf16_t*)(a.ws + (MODE == 0 ? WS_WIN : MODE == 1 ? WS_WOUT : MODE == 2 ? WS_WGU : WS_WDN)) + (size_t)layer * NP * K;
#pragma unroll 8
    for (int i = 0; i < 32; ++i) { const int kk = 2 * i + (lane >> 5); scr[kk * 33 + (lane & 31)] = src[(size_t)(k0 + kk) * N + col]; }
    asm volatile("s_waitcnt lgkmcnt(0)" ::: "memory");
    const int c = lane & 7;
#pragma unroll
    for (int j = 0; j < 4; ++j) {
        const int n = (lane >> 3) + 8 * j; const LAS float* s = scr + (8 * c) * 33 + n;
        u32x4 o; o.x = pk2(s[0 * 33], s[1 * 33]); o.y = pk2(s[2 * 33], s[3 * 33]); o.z = pk2(s[4 * 33], s[5 * 33]); o.w = pk2(s[6 * 33], s[7 * 33]);
        *(u32x4*)(WT + (size_t)(n0 + n) * K + k0 + 8 * c) = o;
    }
    asm volatile("s_waitcnt lgkmcnt(0)" ::: "memory");
}

__device__ __forceinline__ void norm_row(const float* xrow, const float* g, bf16_t* orow, int lane) {
    f32x4 v[4]; float s = 0.f;
#pragma unroll
    for (int j = 0; j < 4; ++j) { v[j] = *(const f32x4*)(xrow + 4 * lane + 256 * j); s += (v[j][0] * v[j][0] + v[j][1] * v[j][1]) + (v[j][2] * v[j][2] + v[j][3] * v[j][3]); }
    const float rstd = rsqrtf(wave_sum(s) * (1.0f / DM) + EPS);
#pragma unroll
    for (int j = 0; j < 4; ++j) {
        const f32x4 gg = *(const f32x4*)(g + 4 * lane + 256 * j); const f32x4 y = v[j] * rstd * gg;
        u32x2 w; w.x = pk2(y[0], y[1]); w.y = pk2(y[2], y[3]); *(u32x2*)(orow + 4 * lane + 256 * j) = w;
    }
}

__device__ __forceinline__ void hyena_raw4(const Args& a, int L, int t0, LAS float* scr, int lane) {
    const float* w1 = a.in[11] + L * 33 * 64; const float* b1 = a.in[12] + L * 64; const float* fr = a.in[13] + L * 128;
    const float* w2 = a.in[14] + L * 64 * 64; const float* b2 = a.in[15] + L * 64; const float* w3 = a.in[16] + (size_t)L * 64 * 1024; const float* dec = a.in[17] + L * 1024;
#pragma unroll 1
    for (int p = 0; p < 4; ++p) {
        const int t = t0 + p;
        LAS float* sp = scr + 192 * p;
        const float tl = (float)t * (1.0f / 2047.0f);
        if (lane < 33) {
            float z;
            if (lane == 0) z = tl;
            else {
                const int k = (lane - 1) & 15;
                const float band = 1e-4f + (float)k * ((15.0f - 1e-4f) / 15.0f);
                const float ang = 2.0f * 3.14159265358979323846f * band * (float)t / 2048.0f;
                z = (lane <= 16) ? cosf(ang) : -sinf(ang);
            }
            sp[lane] = z;
        }
        asm volatile("s_waitcnt lgkmcnt(0)" ::: "memory");
        float h = b1[lane];
        {
            float wv[33];
#pragma unroll
            for (int j = 0; j < 33; ++j) wv[j] = w1[j * 64 + lane];
#pragma unroll
            for (int j = 0; j < 33; ++j) h += sp[j] * wv[j];
        }
        h = sinf(fr[lane] * h);
        sp[64 + lane] = h;
        asm volatile("s_waitcnt lgkmcnt(0)" ::: "memory");
        float h2 = b2[lane];
#pragma unroll 1
        for (int k0 = 0; k0 < 64; k0 += 32) {
            float wv[32];
#pragma unroll
            for (int k = 0; k < 32; ++k) wv[k] = w2[(k0 + k) * 64 + lane];
#pragma unroll
            for (int k = 0; k < 32; ++k) h2 += sp[64 + k0 + k] * wv[k];
        }
        h2 = sinf(fr[64 + lane] * h2);
        sp[128 + lane] = h2;
        asm volatile("s_waitcnt lgkmcnt(0)" ::: "memory");
    }
    float o[4][16];
#pragma unroll
    for (int p = 0; p < 4; ++p)
#pragma unroll
        for (int mth = 0; mth < 16; ++mth) o[p][mth] = 0.f;
#pragma unroll 1
    for (int k0 = 0; k0 < 64; k0 += 4) {
        float wv[4][16];
#pragma unroll
        for (int k = 0; k < 4; ++k)
#pragma unroll
            for (int mth = 0; mth < 16; ++mth) wv[k][mth] = w3[(k0 + k) * 1024 + lane + 64 * mth];
#pragma unroll
        for (int p = 0; p < 4; ++p)
#pragma unroll
            for (int k = 0; k < 4; ++k) { const float hk = scr[192 * p + 128 + k0 + k];
#pragma unroll
                for (int mth = 0; mth < 16; ++mth) o[p][mth] += hk * wv[k][mth]; }
    }
#pragma unroll
    for (int p = 0; p < 4; ++p) {
        const float tl = (float)(t0 + p) * (1.0f / 2047.0f);
        float* raw = (float*)(a.ws + WS_HRAW) + ((size_t)L * 2048 + t0 + p) * 1024;
#pragma unroll
        for (int mth = 0; mth < 16; ++mth) { const int idx = lane + 64 * mth; raw[idx] = o[p][mth] * expf(-tl * dec[idx]); }
    }
    asm volatile("s_waitcnt lgkmcnt(0)" ::: "memory");
}

__device__ __forceinline__ void phase0(const Args& a, LAS unsigned char* lds) {
    const int tid = tidx(), wid = tid >> 6, lane = tid & 63;
    const int gw = blockIdx.x * 8 + wid, NGW = gridDim.x * 8;
    LAS float* scr = (LAS float*)(lds + wid * 16384);
    for (int i = blockIdx.x * 512 + tid; i < 2048 * 32 + 64 * 16; i += gridDim.x * 512) {
        if (i < 2048 * 32) {
            const int s = i >> 5, d = i & 31; const double f = pow(10000.0, -(double)d / 32.0), ang = (double)s * f;
            ((float*)(a.ws + WS_RAC))[i] = (float)cos(ang); ((float*)(a.ws + WS_RAS))[i] = (float)sin(ang);
        } else {
            const int k = i - 2048 * 32, p = k >> 4, d = k & 15; const double f = pow(10000.0, -(double)d / 16.0), ang = (double)p * f;
            ((float*)(a.ws + WS_RCC))[k] = (float)cos(ang); ((float*)(a.ws + WS_RCS))[k] = (float)sin(ang);
        }
    }
    constexpr int I0 = 16 * 80, I1 = 16 * 32, I2 = 16 * 176, I3 = 44 * 32, IL = I0 + I1 + I2 + I3;
    for (int it = gw; it < 2 * IL; it += NGW) {
        const int layer = it / IL; int r = it % IL;
        if (r < I0) { transpose_item<0>(a, layer, r, scr, lane); continue; } r -= I0;
        if (r < I1) { transpose_item<1>(a, layer, r, scr, lane); continue; } r -= I1;
        if (r < I2) { transpose_item<2>(a, layer, r, scr, lane); continue; } r -= I2;
        transpose_item<3>(a, layer, r, scr, lane);
    }
    for (int it = gw; it < 2 * 512; it += NGW) hyena_raw4(a, it >> 9, (it & 511) * 4, scr, lane);
    for (int r = gw * 32; r < MTOK; r += NGW * 32) {
#pragma unroll 1
        for (int k = 0; k < 32; k += 4) {
            f32x4 v[4][4];
#pragma unroll
            for (int u = 0; u < 4; ++u)
#pragma unroll
                for (int j = 0; j < 4; ++j) v[u][j] = *(const f32x4*)(a.in[0] + (size_t)(r + k + u) * DM + 4 * lane + 256 * j);
#pragma unroll
            for (int u = 0; u < 4; ++u) {
                float s = 0.f;
#pragma unroll
                for (int j = 0; j < 4; ++j) s += (v[u][j][0] * v[u][j][0] + v[u][j][1] * v[u][j][1]) + (v[u][j][2] * v[u][j][2] + v[u][j][3] * v[u][j][3]);
                const float rstd = rsqrtf(wave_sum(s) * (1.0f / DM) + EPS);
                bf16_t* orow = (bf16_t*)(a.ws + WS_H) + (size_t)(r + k + u) * DM;
#pragma unroll
                for (int j = 0; j < 4; ++j) { const f32x4 gg = *(const f32x4*)(a.in[1] + 4 * lane + 256 * j); const f32x4 y = v[u][j] * rstd * gg; u32x2 w; w.x = pk2(y[0], y[1]); w.y = pk2(y[2], y[3]); *(u32x2*)(orow + 4 * lane + 256 * j) = w; }
            }
        }
    }
}

__device__ __forceinline__ void gload32(u32x4 (&r)[4], const unsigned char* ubase, unsigned pitch, int lane) {
#pragma unroll
    for (int i = 0; i < 4; ++i) { const unsigned rr = (unsigned)(lane >> 3) + 8u * i; r[i] = *(const u32x4*)(ubase + rr * pitch + (unsigned)(lane & 7) * 16u); }
}
template <bool SWZ>
__device__ __forceinline__ void lwrite32(LAS unsigned char* dst, const u32x4 (&r)[4], int lane) {
#pragma unroll
    for (int i = 0; i < 4; ++i) { const int rr = (lane >> 3) + 8 * i; const int pc = SWZ ? ((lane & 7) ^ ((rr >> 1) & 7)) : (lane & 7); *(LAS u32x4*)(dst + rr * 128 + pc * 16) = r[i]; }
}
__device__ __forceinline__ void load_kf(LAS const unsigned char* kb, bf16x8 (&kf)[4], int lane) {
    const int kl = lane & 31, h = lane >> 5;
#pragma unroll
    for (int s = 0; s < 4; ++s) { const int pc = (2 * s + h) ^ ((kl >> 1) & 7); kf[s] = *(const LAS bf16x8*)(kb + kl * 128 + pc * 16); }
}
__device__ __forceinline__ void load_vf(LAS const unsigned char* vb, bf16x8 (&vf)[2][2], int lane) {
    const int h = lane >> 5, i16 = lane & 15, q = i16 >> 2, p = i16 & 3, dbase = ((lane >> 4) & 1) * 16;
#pragma unroll
    for (int s2 = 0; s2 < 2; ++s2)
#pragma unroll
        for (int dt = 0; dt < 2; ++dt) {
            const int key = 16 * s2 + 4 * h + q, d0 = 32 * dt + dbase + 4 * p;
            const bf16x4 lo = __builtin_amdgcn_ds_read_tr16_b64_v4i16((LAS bf16x4*)(vb + key * 128 + d0 * 2));
            const bf16x4 hi = __builtin_amdgcn_ds_read_tr16_b64_v4i16((LAS bf16x4*)(vb + (key + 8) * 128 + d0 * 2));
            vf[s2][dt] = (bf16x8){lo[0], lo[1], lo[2], lo[3], hi[0], hi[1], hi[2], hi[3]};
        }
}
template <bool KLDS>
__device__ __forceinline__ void attn_step(const bf16x8 (&kf)[4], LAS const unsigned char* kb, const bf16x8 (&vf)[2][2], const bf16x8 (&qf)[4], f32x16& o0, f32x16& o1, float& m, float& l, int lane, int maskmode) {
    const int ql = lane & 31, h = lane >> 5;
    f32x16 S;
#pragma unroll
    for (int i = 0; i < 16; ++i) S[i] = 0.f;
#pragma unroll
    for (int s = 0; s < 4; ++s) {
        if (KLDS) { const int pc = (2 * s + h) ^ ((ql >> 1) & 7); const bf16x8 k1 = *(const LAS bf16x8*)(kb + ql * 128 + pc * 16); S = __builtin_amdgcn_mfma_f32_32x32x16_bf16(k1, qf[s], S, 0, 0, 0); }
        else S = __builtin_amdgcn_mfma_f32_32x32x16_bf16(kf[s], qf[s], S, 0, 0, 0);
    }
    if (maskmode) {
#pragma unroll
        for (int i = 0; i < 16; ++i) { const int kr = (i & 3) + 8 * (i >> 2) + 4 * h; const bool ok = (maskmode == 1) ? (kr >= ql) : (kr <= ql); S[i] = ok ? S[i] : -1e30f; }
    }
    float tm = S[0];
#pragma unroll
    for (int i = 1; i < 16; ++i) tm = fmaxf(tm, S[i]);
    tm = fmaxf(tm, __shfl_xor(tm, 32));
    const float mn = fmaxf(m, tm), al = fexp2(m - mn); m = mn;
    float ps = 0.f;
#pragma unroll
    for (int i = 0; i < 16; ++i) { S[i] = fexp2(S[i] - mn); ps += S[i]; }
    l = l * al + ps;
#pragma unroll
    for (int i = 0; i < 16; ++i) { o0[i] *= al; o1[i] *= al; }
    bf16x8 pf[2];
#pragma unroll
    for (int s2 = 0; s2 < 2; ++s2) {
        u32x4 w; w.x = pk2n(S[8 * s2 + 0], S[8 * s2 + 1]); w.y = pk2n(S[8 * s2 + 2], S[8 * s2 + 3]); w.z = pk2n(S[8 * s2 + 4], S[8 * s2 + 5]); w.w = pk2n(S[8 * s2 + 6], S[8 * s2 + 7]);
        pf[s2] = __builtin_bit_cast(bf16x8, w);
    }
#pragma unroll
    for (int s2 = 0; s2 < 2; ++s2) {
        o0 = __builtin_amdgcn_mfma_f32_32x32x16_bf16(vf[s2][0], pf[s2], o0, 0, 0, 0);
        o1 = __builtin_amdgcn_mfma_f32_32x32x16_bf16(vf[s2][1], pf[s2], o1, 0, 0, 0);
    }
}

__device__ __forceinline__ void attnA_unit(const Args& a, int unit, LAS unsigned char* lds) {
    const int tid = tidx(), wid = __builtin_amdgcn_readfirstlane(tid >> 6), lane = tid & 63, ql = lane & 31, h = lane >> 5;
    const int b = unit / 24, rem = unit % 24, hh = rem >> 2, blk = rem & 3;
    const bf16_t* P = (const bf16_t*)(a.ws + WS_P);
    bf16_t* OA = (bf16_t*)(a.ws + OFF_OA); float* LSE = (float*)(a.ws + OFF_LSE); bf16_t* MIX = (bf16_t*)(a.ws + WS_MIX);
    LAS unsigned char* wl = lds + wid * 8192;
    const unsigned char* kbase = (const unsigned char*)(P + (size_t)b * SEQ * PW + 384 + 64 * hh);
    const unsigned char* vbase = (const unsigned char*)(P + (size_t)b * SEQ * PW + 768 + 64 * hh);
#pragma unroll 1
    for (int pidx = 0; pidx < 3; ++pidx) {
        const int dl = (pidx == 0) ? 1 : (pidx == 1 ? 4 : 16), Ls = SEQ / dl;
        if (pidx == 2) { __syncthreads(); }
#pragma unroll 1
        for (int e = 0; e < 2; ++e) {
            const int qt = 2 * wid + e, r = qt % dl, i0 = (512 * blk) / dl + 32 * (qt / dl);
            const int tq = dl * (i0 + ql) + r;
            bf16x8 qf[4];
            { const bf16_t* qp = P + ((size_t)b * SEQ + tq) * PW + 64 * hh + 8 * h;
#pragma unroll
              for (int s = 0; s < 4; ++s) qf[s] = *(const bf16x8*)(qp + 16 * s); }
            f32x16 o0, o1;
#pragma unroll
            for (int i = 0; i < 16; ++i) { o0[i] = 0.f; o1[i] = 0.f; }
            float m = -1e30f, l = 0.f;
            int kt0 = 0, kt1 = 4;
            if (i0 - 64 < 0) kt0 = (i0 - 32 < 0) ? 2 : 1;
            if (i0 + 64 >= Ls) kt1 = (i0 + 32 >= Ls) ? 2 : 3;
            const unsigned pitch = (unsigned)dl * (PW * 2);
            u32x4 pk[4], pv[4];
            { const size_t ro = (size_t)(dl * (i0 - 64 + 32 * kt0) + r) * (PW * 2); gload32(pk, kbase + ro, pitch, lane); gload32(pv, vbase + ro, pitch, lane); }
#pragma unroll 1
            for (int kt = kt0; kt <= kt1; ++kt) {
                asm volatile("" ::: "memory");
                lwrite32<true>(wl, pk, lane); lwrite32<false>(wl + 4096, pv, lane);
                if (kt < kt1) { const size_t ro = (size_t)(dl * (i0 - 64 + 32 * (kt + 1)) + r) * (PW * 2); gload32(pk, kbase + ro, pitch, lane); gload32(pv, vbase + ro, pitch, lane); }
                asm volatile("s_waitcnt lgkmcnt(0)" ::: "memory");
                bf16x8 kf[4], vf[2][2];
                load_kf(wl, kf, lane); load_vf(wl + 4096, vf, lane);
                attn_step<false>(kf, wl, vf, qf, o0, o1, m, l, lane, kt == 0 ? 1 : (kt == 4 ? 2 : 0));
                asm volatile("" ::: "memory");
            }
            const float lt = l + __shfl_xor(l, 32);
            const float inv = 1.0f / lt, lse = m + __builtin_amdgcn_logf(lt);
            const size_t tokg = (size_t)b * SEQ + tq;
            if (pidx < 2) {
                bf16_t* op = OA + ((size_t)pidx * MTOK + tokg) * 384 + 64 * hh;
#pragma unroll
                for (int dt = 0; dt < 2; ++dt)
#pragma unroll
                    for (int g = 0; g < 4; ++g) {
                        const f32x16& o = dt ? o1 : o0;
                        u32x2 w; w.x = pk2(o[4 * g] * inv, o[4 * g + 1] * inv); w.y = pk2(o[4 * g + 2] * inv, o[4 * g + 3] * inv);
                        *(u32x2*)(op + 32 * dt + 8 * g + 4 * h) = w;
                    }
                if (h == 0) LSE[((size_t)pidx * MTOK + tokg) * 6 + hh] = lse;
            } else {
                const float l1 = LSE[tokg * 6 + hh], l2 = LSE[((size_t)MTOK + tokg) * 6 + hh];
                const float mx = fmaxf(lse, fmaxf(l1, l2));
                const float w1 = fexp2(l1 - mx), w2 = fexp2(l2 - mx), w3 = fexp2(lse - mx);
                const float wi = 1.0f / (w1 + w2 + w3);
                const float c1 = w1 * wi, c2 = w2 * wi, c3 = w3 * wi * inv;
                const bf16_t* p1 = OA + tokg * 384 + 64 * hh; const bf16_t* p2 = OA + ((size_t)MTOK + tokg) * 384 + 64 * hh;
                bf16_t* op = MIX + tokg * DM + 64 * hh;
#pragma unroll
                for (int dt = 0; dt < 2; ++dt)
#pragma unroll
                    for (int g = 0; g < 4; ++g) {
                        const f32x16& o = dt ? o1 : o0;
                        const int d = 32 * dt + 8 * g + 4 * h;
                        const u32x2 a1 = *(const u32x2*)(p1 + d), a2 = *(const u32x2*)(p2 + d);
                        const float r0 = c1 * bflo(a1.x) + c2 * bflo(a2.x) + c3 * o[4 * g], r1 = c1 * bfhi(a1.x) + c2 * bfhi(a2.x) + c3 * o[4 * g + 1];
                        const float r2 = c1 * bflo(a1.y) + c2 * bflo(a2.y) + c3 * o[4 * g + 2], r3 = c1 * bfhi(a1.y) + c2 * bfhi(a2.y) + c3 * o[4 * g + 3];
                        u32x2 w; w.x = pk2(r0, r1); w.y = pk2(r2, r3);
                        *(u32x2*)(op + d) = w;
                    }
            }
        }
    }
}

__device__ __forceinline__ void attnC_unit(const Args& a, int unit, LAS unsigned char* lds) {
    const int tid = tidx(), wid = __builtin_amdgcn_readfirstlane(tid >> 6), lane = tid & 63, ql = lane & 31, h = lane >> 5;
    const int b = unit / 24, rem = unit % 24, hq = rem >> 2, qb = rem & 3, g = hq / 3;
    const bf16_t* P = (const bf16_t*)(a.ws + WS_P);
    bf16_t* MIX = (bf16_t*)(a.ws + WS_MIX);
    const int srow = tid >> 3, sch = tid & 7;
    const unsigned char* kg = (const unsigned char*)(P + ((size_t)b * SEQ + srow) * PW + CK0 + 64 * g) + sch * 16;
    const unsigned char* vg = (const unsigned char*)(P + ((size_t)b * SEQ + srow) * PW + CV0 + 64 * g) + sch * 16;
    const int kwo = srow * 128 + ((sch ^ ((srow >> 1) & 7)) * 16), vwo = 8192 + srow * 128 + sch * 16;
    const size_t tok0 = (size_t)b * SEQ + 512 * qb + 64 * wid + ql;
    bf16x8 qf[2][4]; f32x16 o0[2], o1[2]; float m[2], l[2];
#pragma unroll
    for (int e = 0; e < 2; ++e) {
        const bf16_t* qp = P + (tok0 + 32 * e) * PW + CQ0 + 64 * hq + 8 * h;
#pragma unroll
        for (int s = 0; s < 4; ++s) qf[e][s] = *(const bf16x8*)(qp + 16 * s);
#pragma unroll
        for (int i = 0; i < 16; ++i) { o0[e][i] = 0.f; o1[e][i] = 0.f; }
        m[e] = -1e30f; l[e] = 0.f;
    }
    constexpr size_t TSTEP = (size_t)64 * PW * 2;
    u32x4 rk = *(const u32x4*)kg, rv = *(const u32x4*)vg;
    __syncthreads();
    *(LAS u32x4*)(lds + kwo) = rk; *(LAS u32x4*)(lds + vwo) = rv;
    rk = *(const u32x4*)(kg + TSTEP); rv = *(const u32x4*)(vg + TSTEP);
    __syncthreads();
#pragma unroll 1
    for (int kt = 0; kt < 32; ++kt) {
        LAS unsigned char* cur = lds + (kt & 1) * 16384;
        LAS unsigned char* nxt = lds + ((kt + 1) & 1) * 16384;
        if (kt + 1 < 32) { *(LAS u32x4*)(nxt + kwo) = rk; *(LAS u32x4*)(nxt + vwo) = rv; }
        if (kt + 2 < 32) { rk = *(const u32x4*)(kg + (size_t)(kt + 2) * TSTEP); rv = *(const u32x4*)(vg + (size_t)(kt + 2) * TSTEP); }
#pragma unroll
        for (int j = 0; j < 2; ++j) {
            bf16x8 kf[4], vf[2][2];
            load_kf(cur + j * 4096, kf, lane); load_vf(cur + 8192 + j * 4096, vf, lane);
#pragma unroll
            for (int e = 0; e < 2; ++e) attn_step<false>(kf, cur, vf, qf[e], o0[e], o1[e], m[e], l[e], lane, 0);
        }
        __syncthreads();
    }
#pragma unroll
    for (int e = 0; e < 2; ++e) {
        const float lt = l[e] + __shfl_xor(l[e], 32), inv = 1.0f / lt;
        bf16_t* op = MIX + (tok0 + 32 * e) * DM + 640 + 64 * hq;
#pragma unroll
        for (int dt = 0; dt < 2; ++dt)
#pragma unroll
            for (int gg = 0; gg < 4; ++gg) {
                const f32x16& oo = dt ? o1[e] : o0[e];
                u32x2 w; w.x = pk2(oo[4 * gg] * inv, oo[4 * gg + 1] * inv); w.y = pk2(oo[4 * gg + 2] * inv, oo[4 * gg + 3] * inv);
                *(u32x2*)(op + 32 * dt + 8 * gg + 4 * h) = w;
            }
    }
}

constexpr int HY_CP = 8192 + 16;
__device__ __forceinline__ void hy_filter(const Args& a, int L, int order, int c, LAS unsigned char* lds) {
    const int tid = tidx();
    LAS float* tmp = (LAS float*)(lds + 66048);
    LAS float* red = (LAS float*)(lds + 66048 + 16384);
    const float* raw = (const float*)(a.ws + WS_HRAW) + (size_t)L * 2048 * 1024 + order * 512 + c;
    float s = 0.f;
    for (int i = tid; i < 4096; i += 512) {
        float v;
        if (i < 2048) v = raw[(size_t)i * 1024];
        else if (i == 2048) v = 0.f;
        else v = raw[(size_t)(4096 - i) * 1024 + 256];
        tmp[i] = v; s += fabsf(v);
    }
    s = wave_sum(s);
    if ((tid & 63) == 0) red[tid >> 6] = s;
    __syncthreads();
    float tot = 0.f;
#pragma unroll
    for (int w = 0; w < 8; ++w) tot += red[w];
    const float inv = 1.0f / tot;
    for (int i = tid; i < 8 * 4096; i += 512) {
        const int q = i >> 12, x = i & 4095;
        const float v = tmp[(q - x) & 4095] * inv;
        *(LAS bf16_t*)(lds + q * HY_CP + x * 2) = (bf16_t)(pk2(v, 0.f) & 0xffffu);
    }
    __syncthreads();
}
template <int EPI>
__device__ __forceinline__ void hy_conv(const Args& a, int L, int c, const bf16_t* U, LAS unsigned char* lds) {
    const int tid = tidx(), wid = tid >> 6, lane = tid & 63, n = lane & 31, h = lane >> 5;
    const bf16_t* UC = (const bf16_t*)(a.ws + OFF_UC);
    bf16_t* Z = (bf16_t*)(a.ws + OFF_Z) + (size_t)c * MTOK;
    bf16_t* MIX = (bf16_t*)(a.ws + WS_MIX);
    const float dbias = a.in[18][L * 512 + EPI * 256 + c];
    const bf16_t* urow = U + (size_t)n * SEQ + 8 * h;
    LAS const unsigned char* fbase = lds + (n & 7) * HY_CP;
    const int foff = 8 * h - (n & ~7);
#pragma unroll 1
    for (int blk = 0; blk < 2; ++blk) {
        const int tb = 8 * wid + 4 * blk;
        f32x16 acc[4];
#pragma unroll
        for (int tt = 0; tt < 4; ++tt)
#pragma unroll
            for (int i = 0; i < 16; ++i) acc[tt][i] = 0.f;
        bf16x8 an[4];
#pragma unroll
        for (int k = 0; k < 4; ++k) an[k] = *(const bf16x8*)(urow + 16 * k);
#pragma unroll 1
        for (int s0 = 0; s0 < SEQ; s0 += 64) {
            bf16x8 ac[4];
#pragma unroll
            for (int k = 0; k < 4; ++k) ac[k] = an[k];
            if (s0 + 64 < SEQ) {
#pragma unroll
                for (int k = 0; k < 4; ++k) an[k] = *(const bf16x8*)(urow + s0 + 64 + 16 * k);
            }
            bf16x8 bfr[10];
            const int D0 = s0 - 32 * tb + foff;
#pragma unroll
            for (int d = 0; d < 10; ++d) { const int x = (D0 + 16 * (d - 6)) & 4095; bfr[d] = *(const LAS bf16x8*)(fbase + x * 2); }
#pragma unroll
            for (int k = 0; k < 4; ++k)
#pragma unroll
                for (int tt = 0; tt < 4; ++tt) acc[tt] = __builtin_amdgcn_mfma_f32_32x32x16_bf16(ac[k], bfr[k - 2 * tt + 6], acc[tt], 0, 0, 0);
        }
#pragma unroll
        for (int tt = 0; tt < 4; ++tt)
#pragma unroll
            for (int i = 0; i < 16; ++i) {
                const int bb = (i & 3) + 8 * (i >> 2) + 4 * h, t = 32 * (tb + tt) + n;
                const size_t tok = (size_t)bb * SEQ + t;
                if (EPI == 0) {
                    const float v = bf2f(UC[(size_t)c * MTOK + tok]), x1 = bf2f(UC[((size_t)256 + c) * MTOK + tok]);
                    const float z = x1 * (acc[tt][i] + dbias * v);
                    Z[tok] = (bf16_t)(pk2(z, 0.f) & 0xffffu);
                } else {
                    const float zz = bf2f(Z[tok]), x2 = bf2f(UC[((size_t)512 + c) * MTOK + tok]);
                    const float o = x2 * (acc[tt][i] + dbias * zz);
                    MIX[tok * DM + 384 + c] = (bf16_t)(pk2(o, 0.f) & 0xffffu);
                }
            }
    }
}
__device__ __forceinline__ void hyena_unit(const Args& a, int L, int c, LAS unsigned char* lds) {
    const int tid = tidx();
    const bf16_t* UT = (const bf16_t*)(a.ws + OFF_UT);
    bf16_t* UC = (bf16_t*)(a.ws + OFF_UC);
    const float* cwp = a.in[9] + L * 3 * 768; const float* cbp = a.in[10] + L * 768;
#pragma unroll 1
    for (int k3 = 0; k3 < 3; ++k3) {
        const int hc = 256 * k3 + c;
        const float w0 = cwp[hc], w1 = cwp[768 + hc], w2 = cwp[1536 + hc], bb = cbp[hc];
        const bf16_t* src = UT + (size_t)hc * MTOK; bf16_t* dst = UC + (size_t)hc * MTOK;
        for (int ck = tid; ck < MTOK / 8; ck += 512) {
            const int t0 = ck * 8, s = t0 & 2047;
            const u32x4 v = *(const u32x4*)(src + t0);
            float x[10];
            x[0] = (s == 0) ? 0.f : bf2f(src[t0 - 1]);
            x[1] = bflo(v.x); x[2] = bfhi(v.x); x[3] = bflo(v.y); x[4] = bfhi(v.y); x[5] = bflo(v.z); x[6] = bfhi(v.z); x[7] = bflo(v.w); x[8] = bfhi(v.w);
            x[9] = (s == 2040) ? 0.f : bf2f(src[t0 + 8]);
            float y[8];
#pragma unroll
            for (int j = 0; j < 8; ++j) y[j] = w0 * x[j] + w1 * x[j + 1] + w2 * x[j + 2] + bb;
            u32x4 o; o.x = pk2(y[0], y[1]); o.y = pk2(y[2], y[3]); o.z = pk2(y[4], y[5]); o.w = pk2(y[6], y[7]);
            *(u32x4*)(dst + t0) = o;
        }
    }
    __syncthreads();
    hy_filter(a, L, 0, c, lds);
    hy_conv<0>(a, L, c, UC + (size_t)c * MTOK, lds);
    __syncthreads();
    hy_filter(a, L, 1, c, lds);
    hy_conv<1>(a, L, c, (const bf16_t*)(a.ws + OFF_Z) + (size_t)c * MTOK, lds);
    __syncthreads();
}

__device__ __forceinline__ void row_pass(const bf16_t* F, const float* xold, float* xnew, const float* gpost, const float* gnext, bf16_t* H, int G, int c) {
    const int tid = tidx(), wid = tid >> 6; int lane = tid & 63; asm volatile("" : "+v"(lane));
    f32x4 gp[4], gn[4];
#pragma unroll
    for (int j = 0; j < 4; ++j) { gp[j] = *(const f32x4*)(gpost + 4 * lane + 256 * j); gn[j] = gnext ? *(const f32x4*)(gnext + 4 * lane + 256 * j) : (f32x4){0.f, 0.f, 0.f, 0.f}; }
    for (int rb = (c * 8 + wid) * 32; rb < MTOK; rb += G * 8 * 32) {
#pragma unroll 1
        for (int k = 0; k < 32; k += 4) {
            u32x2 fw[4][4]; f32x4 x[4][4];
#pragma unroll
            for (int u = 0; u < 4; ++u) {
                const size_t ro = (size_t)(rb + k + u) * DM + 4 * lane;
#pragma unroll
                for (int j = 0; j < 4; ++j) { fw[u][j] = *(const u32x2*)(F + ro + 256 * j); x[u][j] = *(const f32x4*)(xold + ro + 256 * j); }
            }
#pragma unroll
            for (int u = 0; u < 4; ++u) {
                const size_t ro = (size_t)(rb + k + u) * DM + 4 * lane;
                f32x4 f[4]; float s = 0.f;
#pragma unroll
                for (int j = 0; j < 4; ++j) { f[j] = (f32x4){bflo(fw[u][j].x), bfhi(fw[u][j].x), bflo(fw[u][j].y), bfhi(fw[u][j].y)}; s += (f[j][0] * f[j][0] + f[j][1] * f[j][1]) + (f[j][2] * f[j][2] + f[j][3] * f[j][3]); }
                const float rstd = rsqrtf(wave_sum(s) * (1.0f / DM) + EPS);
                float s2 = 0.f;
#pragma unroll
                for (int j = 0; j < 4; ++j) { x[u][j] = x[u][j] + f[j] * rstd * gp[j]; *(f32x4*)(xnew + ro + 256 * j) = x[u][j]; s2 += (x[u][j][0] * x[u][j][0] + x[u][j][1] * x[u][j][1]) + (x[u][j][2] * x[u][j][2] + x[u][j][3] * x[u][j][3]); }
                if (gnext) {
                    const float rstd2 = rsqrtf(wave_sum(s2) * (1.0f / DM) + EPS);
#pragma unroll
                    for (int j = 0; j < 4; ++j) { const f32x4 y = x[u][j] * rstd2 * gn[j]; u32x2 w; w.x = pk2(y[0], y[1]); w.y = pk2(y[2], y[3]); *(u32x2*)(H + ro + 256 * j) = w; }
                }
            }
        }
    }
}

__device__ __forceinline__ void ffn_fixup(const Args& a, int L, int panel) {
    const float* EP = (const float*)(a.ws + OFF_EP); const float* EG = (const float*)(a.ws + OFF_EG); const float* EU = (const float*)(a.ws + OFF_EU);
    bf16_t* ACT = (bf16_t*)(a.ws + WS_P);
    const float* cw = a.in[21] + (size_t)L * 3 * FF;
    int tid0 = tidx(); asm volatile("" : "+v"(tid0));
    for (int i = tid0; i < 8 * FF; i += 512) {
        const int e = i / FF, c = i % FF, gi = 4 * panel + (e >> 1), side = e & 1;
        const int row = 64 * gi + (side ? 63 : 0);
        const size_t eo = ((size_t)gi * 2 + side) * FF + c;
        float nb = 0.f, w;
        if (side == 0) { w = cw[c]; if ((row & 2047) != 0) nb = EG[((size_t)(gi - 1) * 2 + 1) * FF + c]; }
        else { w = cw[2 * FF + c]; if ((row & 2047) != 2047) nb = EG[((size_t)(gi + 1) * 2) * FF + c]; }
        const float pre = EP[eo] + w * nb;
        const float act = gelu_tanh(pre) * EU[eo];
        ACT[(size_t)row * FF + c] = (bf16_t)(pk2(act, 0.f) & 0xffffu);
    }
}

__device__ __forceinline__ void run_phase(const Args& a0, int ph, LAS unsigned char* lds) {
    Args a = a0;
#pragma unroll
    for (int i = 0; i < 24; ++i) { const __attribute__((address_space(1))) float* p = (const __attribute__((address_space(1))) float*)a0.in[i]; asm volatile("" : "+s"(p)); a.in[i] = (const float*)p; }
    { __attribute__((address_space(1))) float* p = (__attribute__((address_space(1))) float*)a0.out; asm volatile("" : "+s"(p)); a.out = (float*)p; }
    { __attribute__((address_space(1))) unsigned char* p = (__attribute__((address_space(1))) unsigned char*)a0.ws; asm volatile("" : "+s"(p)); a.ws = (unsigned char*)p; }
    int G = gridDim.x, c = blockIdx.x; asm volatile("" : "+s"(G), "+s"(c));
#ifndef PHM
#define PHM 63
#endif
    if (ph == 0) { for (int rep = 0; rep < NREP(32); ++rep) { phase0(a, lds); __syncthreads(); } return; }
    const int L = (ph - 1) / 7, sub = (ph - 1) % 7;
    bf16_t* H = (bf16_t*)(a.ws + WS_H);
    bf16_t* Fb = (bf16_t*)(a.ws + WS_F);
    if (sub == 0) {
        pg8::Gemm g{H, (const bf16_t*)(a.ws + WS_WIN) + (size_t)L * PW * DM, MTOK, PW, DM};
        pg8::StaticOrder S; S.init(MTOK, PW, G, c);
        EpiIn E{(bf16_t*)(a.ws + WS_P), (bf16_t*)(a.ws + OFF_UT), (const float*)(a.ws + WS_RAC), (const float*)(a.ws + WS_RAS), (const float*)(a.ws + WS_RCC), (const float*)(a.ws + WS_RCS),
                a.in[7] + L * 64, a.in[8] + L * 64, lds + 131072};
        for (int rep = 0; rep < NREP(8); ++rep) pg8::gemm_phase(lds, g, S, E);
    } else if (sub == 1) {
        for (int rep = 0; rep < NREP(1); ++rep) for (int ch = c; ch < 256; ch += G) hyena_unit(a, L, ch, lds);
        for (int rep = 0; rep < NREP(2); ++rep) for (int u = c; u < 768; u += G) attnC_unit(a, u, lds);
        for (int rep = 0; rep < NREP(4); ++rep) { __syncthreads(); for (int u = c; u < 768; u += G) attnA_unit(a, u, lds); }
    } else if (sub == 2) {
        pg8::Gemm g{(const bf16_t*)(a.ws + WS_MIX), (const bf16_t*)(a.ws + WS_WOUT) + (size_t)L * DM * DM, MTOK, DM, DM};
        pg8::StaticOrder S; S.init(MTOK, DM, G, c); EpiF E{Fb};
        for (int rep = 0; rep < NREP(64); ++rep) pg8::gemm_phase(lds, g, S, E);
    } else if (sub == 3) {
        row_pass(Fb, L == 0 ? a.in[0] : a.out, a.out, a.in[2] + L * DM, a.in[3] + L * DM, H, G, c);
    } else if (sub == 4) {
        pg8::Gemm g{H, (const bf16_t*)(a.ws + WS_WGU) + (size_t)L * 2 * FF * DM, MTOK, 2 * FF, DM};
        pg8::StaticOrder S; S.init(MTOK, 2 * FF, G, c);
        EpiGU E{(bf16_t*)(a.ws + WS_P), (float*)(a.ws + OFF_EP), (float*)(a.ws + OFF_EG), (float*)(a.ws + OFF_EU), a.in[21] + (size_t)L * 3 * FF, a.in[22] + (size_t)L * FF};
        for (int rep = 0; rep < NREP(16); ++rep) pg8::gemm_phase(lds, g, S, E);
    } else if (sub == 5) {
        pg8::Gemm g{(const bf16_t*)(a.ws + WS_P), (const bf16_t*)(a.ws + WS_WDN) + (size_t)L * DM * FF, MTOK, DM, FF};
        pg8::StaticOrder S; S.init(MTOK, DM, G, c); EpiF E{Fb};
        { Unit u; int last = -1; for (int i = 0; S.next(i, u); ++i) if (u.pm != last) { ffn_fixup(a, L, u.pm); last = u.pm; } }
        __syncthreads();
        pg8::gemm_phase(lds, g, S, E);
    } else {
        row_pass(Fb, a.out, a.out, a.in[4] + L * DM, L == 0 ? a.in[1] + DM : nullptr, H, G, c);
    }
}

#define XB_TMO      128
#define XB_XCNT(j)  (256  + 64 * (j))
#define XB_XSUB(j)  (1280 + 64 * (j))
#define XB_XGEN(j)  (2304 + 64 * (j))
#define XB_TOP      3328
#define XB_TOPGEN   3392
#define XB_SPIN_CAP (1u << 22)
__device__ __forceinline__ unsigned xb_ld(unsigned* p)              { return __hip_atomic_load(p, __ATOMIC_RELAXED, __HIP_MEMORY_SCOPE_AGENT); }
__device__ __forceinline__ unsigned xb_add(unsigned* p, unsigned v) { return __hip_atomic_fetch_add(p, v, __ATOMIC_RELAXED, __HIP_MEMORY_SCOPE_AGENT); }
__device__ __forceinline__ unsigned xb_xcc_id() { return (unsigned)__builtin_amdgcn_s_getreg((3 << 11) | 20) & 0xFu; }
#define XB_SPIN(cond, bar) do { unsigned _sp = 0; while (cond) { __builtin_amdgcn_s_sleep(1); \
    if ((++_sp & 255u) == 0u) { if (xb_ld(&(bar)[XB_TMO])) break; if (_sp > XB_SPIN_CAP) { atomicAdd(&(bar)[XB_TMO], 1u); break; } } } } while (0)
struct XbCensus { unsigned nloc, nx; };
__device__ __forceinline__ XbCensus xcd_barrier_complete(unsigned* bar, unsigned x) {
    const unsigned G = gridDim.x;
    unsigned sum, cnt, mine, sp = 0u;
    for (;;) {
        sum = 0u; cnt = 0u; mine = 0u;
#pragma unroll
        for (unsigned j = 0; j < 16; ++j) { const unsigned c = xb_ld(&bar[XB_XCNT(j)]); sum += c; cnt += (c > 0u) ? 1u : 0u; mine = (j == x) ? c : mine; }
        if (sum == G) break;
        __builtin_amdgcn_s_sleep(1);
        if ((++sp & 255u) == 0u) { if (xb_ld(&bar[XB_TMO])) break; if (sp > XB_SPIN_CAP) { atomicAdd(&bar[XB_TMO], 1u); break; } }
    }
    XbCensus r; r.nloc = mine > 0u ? mine : 1u; r.nx = cnt > 0u ? cnt : 1u; return r;
}
__device__ __forceinline__ void xcd_barrier(unsigned* bar, unsigned x, bool first) {
    asm volatile("s_waitcnt vmcnt(0)" ::: "memory");
    __syncthreads();
    if (threadIdx.x == 0) {
        __builtin_amdgcn_s_waitcnt(0);
        unsigned* slot = bar + 4096 + 2 * blockIdx.x;
        XbCensus cs;
        if (first) { cs = xcd_barrier_complete(bar, x); slot[0] = cs.nloc; slot[1] = cs.nx; }
        else { cs.nloc = xb_ld(slot); cs.nx = xb_ld(slot + 1); }
        const unsigned nloc = cs.nloc, nx = cs.nx;
        const unsigned old = xb_add(&bar[XB_XSUB(x)], 1u);
        const unsigned gen = old / nloc;
        if (old + 1u == (gen + 1u) * nloc) {
            __builtin_amdgcn_fence(__ATOMIC_RELEASE, "agent");
            asm volatile("s_waitcnt vmcnt(0)" ::: "memory");
            const unsigned og = xb_add(&bar[XB_TOP], 1u);
            const unsigned tg = og / nx;
            if (og + 1u == (tg + 1u) * nx) xb_add(&bar[XB_TOPGEN], 1u);
            else XB_SPIN(xb_ld(&bar[XB_TOPGEN]) == tg, bar);
            __builtin_amdgcn_fence(__ATOMIC_ACQUIRE, "agent");
            xb_add(&bar[XB_XGEN(x)], 1u);
            asm volatile("s_waitcnt vmcnt(0)" ::: "memory");
        } else {
            XB_SPIN(xb_ld(&bar[XB_XGEN(x)]) == gen, bar);
            __builtin_amdgcn_fence(__ATOMIC_ACQUIRE, "agent");
            asm volatile("s_waitcnt vmcnt(0)" ::: "memory");
        }
    }
    __syncthreads();
}

__global__ __launch_bounds__(512, 2) void mk_fwd(Args a) {
    extern __shared__ __attribute__((aligned(16))) unsigned char lds_raw[];
    LAS unsigned char* lds = (LAS unsigned char*)lds_raw;
    unsigned* bar = (unsigned*)a.ws;
    unsigned xcc = 0u;
    if (a.coop) { xcc = xb_xcc_id(); if (threadIdx.x == 0) (void)xb_add(&bar[XB_XCNT(xcc)], 1u); }
    (void)xcc;
    for (int ph = a.ph_lo; ph < a.ph_hi; ++ph) {
        run_phase(a, ph, lds);
        if (a.coop && ph + 1 < a.ph_hi) {
            if (ph == 0) cg::this_grid().sync();
            else xcd_barrier(bar, xb_xcc_id(), ph == 1);
        }
    }
}

extern "C" void kernel_launch(void* const* d_in, const int* in_sizes, int n_in, void* d_out, int out_size, void* d_ws, size_t ws_size, hipStream_t stream) {
    static int grid = 0;
    if (grid == 0) {
        if (n_in != 24 || out_size != MTOK * DM || ws_size < WS_END) { fprintf(stderr, "kernel_launch: unexpected shapes / workspace (n_in %d out %d ws %zu need %zu)\n", n_in, out_size, ws_size, (size_t)WS_END); grid = -1; return; }
        int dev = 0, cus = 0, per_cu = 0;
        hipGetDevice(&dev); hipDeviceGetAttribute(&cus, hipDeviceAttributeMultiprocessorCount, dev);
        if (hipFuncSetAttribute((const void*)mk_fwd, hipFuncAttributeMaxDynamicSharedMemorySize, LDS_BYTES) != hipSuccess) { fprintf(stderr, "kernel_launch: hipFuncSetAttribute failed\n"); grid = -1; return; }
        if (hipOccupancyMaxActiveBlocksPerMultiprocessor(&per_cu, (const void*)mk_fwd, 512, LDS_BYTES) != hipSuccess || per_cu < 1) { fprintf(stderr, "kernel_launch: occupancy query says %d\n", per_cu); per_cu = 1; }
        (void)hipGetLastError();
        grid = cus;
    }
    if (grid < 0) return;
    if (hipMemsetAsync(d_ws, 0, 32768, stream) != hipSuccess) { fprintf(stderr, "kernel_launch: memset of the barrier words failed\n"); return; }
    Args a{};
    for (int i = 0; i < 24; ++i) a.in[i] = (const float*)d_in[i];
    a.out = (float*)d_out; a.ws = (unsigned char*)d_ws;
#if MK_COOP
    a.ph_lo = 0; a.ph_hi = NPH; a.coop = 1;
    void* args[] = {&a};
    hipError_t e = hipLaunchCooperativeKernel((const void*)mk_fwd, dim3(grid), dim3(512), args, LDS_BYTES, stream);
    if (e != hipSuccess) fprintf(stderr, "cooperative launch failed: %s (grid %d)\n", hipGetErrorString(e), grid);
#else
    for (int ph = 0; ph < NPH; ++ph) {
        a.ph_lo = ph; a.ph_hi = ph + 1; a.coop = 0;
        hipLaunchKernelGGL(mk_fwd, dim3(grid), dim3(512), LDS_BYTES, stream, a);
    }
#endif
}
```
